# Optimizing an MI355X kernel written in HIP

```python
import math
import jax
import jax.numpy as jnp
from jax import lax
import numpy as np

D_MODEL = 1024
BATCH = 8
SEQ = 4096
DEPTH = 2

MIX_WIDTH = D_MODEL
N_MIXERS = 4
GROUP_WIDTH = MIX_WIDTH // N_MIXERS
HEAD_DIM = 64
N_HEADS_GROUP = GROUP_WIDTH // HEAD_DIM
ROPE_THETA = 10000.0
NORM_EPS = 1e-6
Q_BLOCK = 128
NEG_INF = -1e30

NSA_CMP_LEN = 32
NSA_CMP_STRIDE = 16
NSA_CMP_HIDDEN = 2 * HEAD_DIM
NSA_SEL_LEN = 64
NSA_TOP_N = 16
NSA_WINDOW = 512
NSA_FORCE_BONUS = 1e3

GDN_CONV = 4
GDN_CHUNK = 64

MLSTM_QK_DIM = HEAD_DIM // 2
MLSTM_CHUNK = 64
MLSTM_GATE_CAP = 15.0

DIFF_SUB_DIM = HEAD_DIM // 2

MEM_TOKENS = 256
MEM_HEADS = 4
MEM_HEAD_DIM = 64

MOE_GROUPS = 4
MOE_EXPERTS_PER_GROUP = 8
MOE_N_EXPERTS = MOE_GROUPS * MOE_EXPERTS_PER_GROUP
MOE_TOP_K = 2
MOE_FF = D_MODEL // 4
MOE_TOKEN_BLOCK = 128

IN_WIDTHS = (
    GROUP_WIDTH, HEAD_DIM, HEAD_DIM, HEAD_DIM, HEAD_DIM, HEAD_DIM, HEAD_DIM, 3 * N_HEADS_GROUP,
    GROUP_WIDTH, GROUP_WIDTH, GROUP_WIDTH, N_HEADS_GROUP, N_HEADS_GROUP, GROUP_WIDTH,
    N_HEADS_GROUP * MLSTM_QK_DIM, N_HEADS_GROUP * MLSTM_QK_DIM, GROUP_WIDTH, N_HEADS_GROUP, N_HEADS_GROUP, GROUP_WIDTH,
    GROUP_WIDTH, GROUP_WIDTH, GROUP_WIDTH,
)
IN_COLS = sum(IN_WIDTHS)

kernel_name = 'hybrid_nsa_gdn_mlstm_diffattn_hmoe'


def rms_norm(x, g):
    xf = x.astype(jnp.float32)
    y = xf * lax.rsqrt(jnp.mean(xf * xf, axis=-1, keepdims=True) + NORM_EPS)
    return (y * g.astype(jnp.float32)).astype(x.dtype)


def l2_normalize(x):
    return x * lax.rsqrt(jnp.sum(x * x, axis=-1, keepdims=True) + NORM_EPS)


def rope_tables(pos, dim):
    inv_freq = 1.0 / (ROPE_THETA ** (jnp.arange(0, dim, 2, dtype=jnp.float32) / dim))
    ang = pos.astype(jnp.float32)[:, None] * inv_freq[None, :]
    return jnp.cos(ang), jnp.sin(ang)


def apply_rope(x, cos, sin):
    x1, x2 = jnp.split(x.astype(jnp.float32), 2, axis=-1)
    return jnp.concatenate([x1 * cos - x2 * sin, x2 * cos + x1 * sin], axis=-1).astype(x.dtype)


def masked_softmax(s, mask):
    p = jax.nn.softmax(jnp.where(mask, s, NEG_INF), axis=-1)
    return jnp.where(mask, p, 0.0)


def soft_cap(x, cap):
    return cap * jnp.tanh(x / cap)


def causal_depthwise_conv(x, w):
    k_len, ch = w.shape
    return lax.conv_general_dilated(
        x, w[:, None, :].astype(x.dtype), window_strides=(1,), padding=[(k_len - 1, 0)],
        dimension_numbers=('NWC', 'WIO', 'NWC'), feature_group_count=ch)


def nsa_overlap(n_cmp, n_sel):
    c0 = NSA_CMP_STRIDE * np.arange(n_cmp)[:, None]
    s0 = NSA_SEL_LEN * np.arange(n_sel)[None, :]
    ov = np.clip(np.minimum(c0 + NSA_CMP_LEN, s0 + NSA_SEL_LEN) - np.maximum(c0, s0), 0, None)
    return (ov / NSA_CMP_STRIDE).astype(np.float32)


def nsa_mixer(q, kc, vc, ks, vs, kw, vw, gates, qk_gain, cmp_pe, cmp_w1, cmp_w2, cos, sin):
    B, S, _ = q.shape
    H, Dh = N_HEADS_GROUP, HEAD_DIM
    scale = Dh ** -0.5
    nb = S // Q_BLOCK
    n_cmp = (S - NSA_CMP_LEN) // NSA_CMP_STRIDE + 1
    n_sel = S // NSA_SEL_LEN
    n_top = min(NSA_TOP_N, n_sel)

    q = apply_rope(rms_norm(q.reshape(B, S, H, Dh), qk_gain[0]).transpose(0, 2, 1, 3), cos, sin)

    cmp_idx = NSA_CMP_STRIDE * np.arange(n_cmp)[:, None] + np.arange(NSA_CMP_LEN)[None, :]
    cmp_end = NSA_CMP_STRIDE * np.arange(n_cmp) + NSA_CMP_LEN - 1

    def compress(t, j):
        blocks = t[:, cmp_idx] + cmp_pe[j]
        hid = jax.nn.gelu(blocks.reshape(B, n_cmp, -1) @ cmp_w1[j])
        return hid @ cmp_w2[j]

    kc = apply_rope(rms_norm(compress(kc, 0), qk_gain[1]), cos[cmp_end], sin[cmp_end])
    vc = compress(vc, 1)
    ks = apply_rope(rms_norm(ks, qk_gain[2]), cos, sin)
    ks_blocks = ks.reshape(B, n_sel, NSA_SEL_LEN, Dh)
    vs_blocks = vs.reshape(B, n_sel, NSA_SEL_LEN, Dh)
    kw = apply_rope(rms_norm(kw, qk_gain[3]), cos, sin)
    kw_pad = jnp.pad(kw, ((0, 0), (NSA_WINDOW, 0), (0, 0)))
    vw_pad = jnp.pad(vw, ((0, 0), (NSA_WINDOW, 0), (0, 0)))
    gates = jax.nn.sigmoid(gates.reshape(B, S, H, 3).transpose(0, 2, 1, 3))
    overlap = jnp.asarray(nsa_overlap(n_cmp, n_sel))
    sel_ids = jnp.arange(n_sel)
    win_offs = jnp.arange(Q_BLOCK + NSA_WINDOW)

    def block(i):
        t0 = i * Q_BLOCK
        t = t0 + jnp.arange(Q_BLOCK)
        qb = lax.dynamic_slice_in_dim(q, t0, Q_BLOCK, axis=2)
        gb = lax.dynamic_slice_in_dim(gates, t0, Q_BLOCK, axis=2)
        s = jnp.einsum('bhqd,bcd->bhqc', qb, kc).astype(jnp.float32) * scale
        p_c = masked_softmax(s, cmp_end[None, :] <= t[:, None])
        o_c = jnp.einsum('bhqc,bcd->bhqd', p_c.astype(vc.dtype), vc)
        imp = jnp.einsum('bhqc,cn->bqn', p_c, overlap)
        cur = t // NSA_SEL_LEN
        valid = sel_ids[None, :] <= cur[:, None]
        forced = (sel_ids[None, :] == 0) | (sel_ids[None, :] == cur[:, None]) | (sel_ids[None, :] == cur[:, None] - 1)
        score = jnp.where(valid, imp + jnp.where(forced, NSA_FORCE_BONUS, 0.0), NEG_INF)
        _, idx = lax.top_k(score, n_top)
        kg = jax.vmap(lambda kb, ix: kb[ix])(ks_blocks, idx)
        vg = jax.vmap(lambda vb, ix: vb[ix])(vs_blocks, idx)
        s = jnp.einsum('bhqd,bqnrd->bhqnr', qb, kg).astype(jnp.float32) * scale
        kpos = idx[..., None] * NSA_SEL_LEN + jnp.arange(NSA_SEL_LEN)
        sel_mask = (kpos <= t[None, :, None, None]).reshape(B, 1, Q_BLOCK, -1)
        p_s = masked_softmax(s.reshape(B, H, Q_BLOCK, -1), sel_mask)
        o_s = jnp.einsum('bhqk,bqkd->bhqd', p_s.astype(vg.dtype), vg.reshape(B, Q_BLOCK, -1, Dh))
        kwb = lax.dynamic_slice_in_dim(kw_pad, t0, Q_BLOCK + NSA_WINDOW, axis=1)
        vwb = lax.dynamic_slice_in_dim(vw_pad, t0, Q_BLOCK + NSA_WINDOW, axis=1)
        spos = t0 - NSA_WINDOW + win_offs
        dist = t[:, None] - spos[None, :]
        w_mask = (dist >= 0) & (dist < NSA_WINDOW) & (spos[None, :] >= 0)
        s = jnp.einsum('bhqd,bkd->bhqk', qb, kwb).astype(jnp.float32) * scale
        p_w = masked_softmax(s, w_mask)
        o_w = jnp.einsum('bhqk,bkd->bhqd', p_w.astype(vwb.dtype), vwb)
        return gb[..., 0:1] * o_c + gb[..., 1:2] * o_s + gb[..., 2:3] * o_w

    out = lax.map(block, jnp.arange(nb))
    return out.transpose(1, 0, 3, 2, 4).reshape(B, S, H * Dh)


def gated_delta_chunked(q, k, v, g, beta):
    B, H, S, Dk = q.shape
    Dv = v.shape[-1]
    C = GDN_CHUNK
    N = S // C
    q = q.reshape(B, H, N, C, Dk)
    k = k.reshape(B, H, N, C, Dk)
    v = v.reshape(B, H, N, C, Dv)
    g = g.reshape(B, H, N, C)
    beta = beta.reshape(B, H, N, C)
    gc = jnp.cumsum(g, axis=-1)
    incl = jnp.tril(jnp.ones((C, C), bool))
    strict = jnp.tril(jnp.ones((C, C), bool), -1)
    decay = jnp.exp(jnp.where(incl, gc[..., :, None] - gc[..., None, :], NEG_INF))
    k_beta = k * beta[..., None]
    a_low = jnp.where(strict, jnp.einsum('bhnid,bhnjd->bhnij', k_beta, k) * decay, 0.0)
    system = a_low + jnp.eye(C, dtype=jnp.float32)
    rhs = jnp.concatenate([v * beta[..., None], k_beta * jnp.exp(gc)[..., None]], axis=-1)
    sol = lax.linalg.triangular_solve(system, rhs, left_side=True, lower=True)
    u, w = sol[..., :Dv], sol[..., Dv:]
    qd = q * jnp.exp(gc)[..., None]
    attn = jnp.einsum('bhnid,bhnjd->bhnij', q, k) * decay
    g_last = gc[..., -1]
    k_end = k * jnp.exp(g_last[..., None] - gc)[..., None]

    def step(state, xs):
        qd_c, w_c, u_c, a_c, ke_c, gl_c = xs
        v_new = u_c - jnp.einsum('bhck,bhkv->bhcv', w_c, state)
        o_c = jnp.einsum('bhck,bhkv->bhcv', qd_c, state) + jnp.einsum('bhcj,bhjv->bhcv', a_c, v_new)
        state = state * jnp.exp(gl_c)[..., None, None] + jnp.einsum('bhck,bhcv->bhkv', ke_c, v_new)
        return state, o_c

    xs = tuple(jnp.moveaxis(t, 2, 0) for t in (qd, w, u, attn, k_end, g_last))
    _, o = lax.scan(step, jnp.zeros((B, H, Dk, Dv), jnp.float32), xs)
    return jnp.moveaxis(o, 0, 2).reshape(B, H, S, Dv)


def gdn_mixer(q, k, v, a, b, z, conv_w, a_log, dt_bias, norm_g):
    B, S, _ = q.shape
    H, Dh = N_HEADS_GROUP, HEAD_DIM
    dtype = q.dtype
    qkv = jax.nn.silu(causal_depthwise_conv(jnp.concatenate([q, k, v], axis=-1), conv_w))
    q, k, v = jnp.split(qkv, 3, axis=-1)
    heads = lambda t: t.reshape(B, S, H, Dh).transpose(0, 2, 1, 3).astype(jnp.float32)
    q = l2_normalize(heads(q)) * Dh ** -0.5
    k = l2_normalize(heads(k))
    v = heads(v)
    beta = jax.nn.sigmoid(b.astype(jnp.float32)).transpose(0, 2, 1)
    g = -jnp.exp(a_log.astype(jnp.float32)) * jax.nn.softplus(a.astype(jnp.float32) + dt_bias.astype(jnp.float32))
    o = gated_delta_chunked(q, k, v, g.transpose(0, 2, 1), beta)
    o = rms_norm(o.transpose(0, 2, 1, 3), norm_g) * jax.nn.silu(z.astype(jnp.float32).reshape(B, S, H, Dh))
    return o.reshape(B, S, H * Dh).astype(dtype)


def mlstm_chunked(q, k, v, i_g, log_f):
    B, H, S, Dk = q.shape
    Dv = v.shape[-1]
    C = MLSTM_CHUNK
    N = S // C
    q = q.reshape(B, H, N, C, Dk)
    k = k.reshape(B, H, N, C, Dk)
    v = v.reshape(B, H, N, C, Dv)
    i_g = i_g.reshape(B, H, N, C)
    b = jnp.cumsum(log_f.reshape(B, H, N, C), axis=-1)
    causal = jnp.tril(jnp.ones((C, C), bool))
    d_log = jnp.where(causal, b[..., :, None] - b[..., None, :] + i_g[..., None, :], NEG_INF)
    a_end = b[..., -1:] - b + i_g
    m_loc = jnp.max(a_end, axis=-1)
    w_end = jnp.exp(a_end - m_loc[..., None])
    c_loc = jnp.einsum('bhncd,bhnce,bhnc->bhnde', k, v, w_end)
    n_loc = jnp.einsum('bhncd,bhnc->bhnd', k, w_end)
    b_last = b[..., -1]

    def step(carry, xs):
        c_st, n_st, m_st = carry
        c_l, n_l, m_l, b_l = xs
        m_new = jnp.maximum(b_l + m_st, m_l)
        s_prev = jnp.exp(b_l + m_st - m_new)
        s_loc = jnp.exp(m_l - m_new)
        c_new = s_prev[..., None, None] * c_st + s_loc[..., None, None] * c_l
        n_new = s_prev[..., None] * n_st + s_loc[..., None] * n_l
        return (c_new, n_new, m_new), (c_st, n_st, m_st)

    init = (jnp.zeros((B, H, Dk, Dv), jnp.float32), jnp.zeros((B, H, Dk), jnp.float32), jnp.zeros((B, H), jnp.float32))
    xs = tuple(jnp.moveaxis(t, 2, 0) for t in (c_loc, n_loc, m_loc, b_last))
    _, (c_in, n_in, m_in) = lax.scan(step, init, xs)
    c_in = jnp.moveaxis(c_in, 0, 2)
    n_in = jnp.moveaxis(n_in, 0, 2)
    m_in = jnp.moveaxis(m_in, 0, 2)
    inter_log = b + m_in[..., None]
    m_t = jnp.maximum(inter_log, jnp.max(d_log, axis=-1))
    w_inter = jnp.exp(inter_log - m_t)
    w_intra = jnp.exp(d_log - m_t[..., None]) * jnp.einsum('bhncd,bhnsd->bhncs', q, k)
    num = w_inter[..., None] * jnp.einsum('bhncd,bhnde->bhnce', q, c_in) + jnp.einsum('bhncs,bhnse->bhnce', w_intra, v)
    den = w_inter * jnp.einsum('bhncd,bhnd->bhnc', q, n_in) + jnp.sum(w_intra, axis=-1)
    h = num / jnp.maximum(jnp.abs(den), jnp.exp(-m_t))[..., None]
    return h.reshape(B, H, S, Dv)


def mlstm_mixer(q, k, v, i_pre, f_pre, o_pre, i_bias, f_bias, norm_g):
    B, S, _ = q.shape
    H = N_HEADS_GROUP
    dtype = q.dtype
    heads = lambda t, d: t.reshape(B, S, H, d).transpose(0, 2, 1, 3).astype(jnp.float32)
    q = heads(q, MLSTM_QK_DIM)
    k = heads(k, MLSTM_QK_DIM) * MLSTM_QK_DIM ** -0.5
    v = heads(v, HEAD_DIM)
    i_g = soft_cap(i_pre.astype(jnp.float32) + i_bias.astype(jnp.float32), MLSTM_GATE_CAP).transpose(0, 2, 1)
    log_f = jax.nn.log_sigmoid(soft_cap(f_pre.astype(jnp.float32) + f_bias.astype(jnp.float32), MLSTM_GATE_CAP)).transpose(0, 2, 1)
    h = mlstm_chunked(q, k, v, i_g, log_f)
    h = rms_norm(h.transpose(0, 2, 1, 3), norm_g) * jax.nn.sigmoid(o_pre.astype(jnp.float32).reshape(B, S, H, HEAD_DIM))
    return h.reshape(B, S, H * HEAD_DIM).astype(dtype)


def diff_mixer(q, k, v, qk_gain, lam, norm_g, lambda_init, cos, sin):
    B, S, _ = q.shape
    H, d = N_HEADS_GROUP, DIFF_SUB_DIM
    nb = S // Q_BLOCK
    q = apply_rope(rms_norm(q.reshape(B, S, H, 2, d).transpose(0, 2, 3, 1, 4), qk_gain[0]), cos, sin)
    k = apply_rope(rms_norm(k.reshape(B, S, H, 2, d).transpose(0, 2, 3, 1, 4), qk_gain[1]), cos, sin)
    v = v.reshape(B, S, H, HEAD_DIM).transpose(0, 2, 1, 3)
    lam = lam.astype(jnp.float32)
    lam_full = jnp.exp(jnp.sum(lam[0] * lam[1])) - jnp.exp(jnp.sum(lam[2] * lam[3])) + lambda_init
    scale = d ** -0.5
    kpos = jnp.arange(S)

    def block(i):
        t0 = i * Q_BLOCK
        qb = lax.dynamic_slice_in_dim(q, t0, Q_BLOCK, axis=3)
        s = jnp.einsum('bhcqd,bhckd->bhcqk', qb, k).astype(jnp.float32) * scale
        p = masked_softmax(s, kpos[None, :] <= (t0 + jnp.arange(Q_BLOCK))[:, None])
        a = p[:, :, 0] - lam_full * p[:, :, 1]
        return jnp.einsum('bhqk,bhkd->bhqd', a.astype(v.dtype), v)

    o = lax.map(block, jnp.arange(nb))
    o = o.transpose(1, 0, 3, 2, 4).reshape(B, S, H, HEAD_DIM)
    o = rms_norm(o, norm_g) * (1.0 - lambda_init)
    return o.reshape(B, S, H * HEAD_DIM)


def memory_cross_attention(hn, memn, wq, wkv, qk_gain, wo):
    B, S, _ = hn.shape
    M = memn.shape[1]
    q = (hn @ wq).reshape(B, S, MEM_HEADS, MEM_HEAD_DIM).transpose(0, 2, 1, 3)
    k, v = jnp.split(memn @ wkv, 2, axis=-1)
    k = k.reshape(B, M, MEM_HEADS, MEM_HEAD_DIM).transpose(0, 2, 1, 3)
    v = v.reshape(B, M, MEM_HEADS, MEM_HEAD_DIM).transpose(0, 2, 1, 3)
    q = rms_norm(q, qk_gain[0])
    k = rms_norm(k, qk_gain[1])
    s = jnp.einsum('bhsd,bhmd->bhsm', q, k).astype(jnp.float32) * MEM_HEAD_DIM ** -0.5
    p = jax.nn.softmax(s, axis=-1)
    o = jnp.einsum('bhsm,bhmd->bhsd', p.astype(v.dtype), v)
    return o.transpose(0, 2, 1, 3).reshape(B, S, MEM_HEADS * MEM_HEAD_DIM) @ wo


def hierarchical_moe(hn, w_group, b_group, w_expert, b_expert, w1, w3, w2):
    B, S, D = hn.shape
    xt = hn.reshape(-1, D)
    T = xt.shape[0]
    grp_prob = jax.nn.softmax((xt @ w_group).astype(jnp.float32) + b_group.astype(jnp.float32), axis=-1)
    grp_p, grp_idx = lax.top_k(grp_prob, 1)
    exp_logits = ((xt @ w_expert).astype(jnp.float32) + b_expert.astype(jnp.float32)).reshape(T, MOE_GROUPS, MOE_EXPERTS_PER_GROUP)
    exp_logits = jnp.take_along_axis(exp_logits, grp_idx[:, :, None], axis=1)[:, 0]
    top_p, top_idx = lax.top_k(jax.nn.softmax(exp_logits, axis=-1), MOE_TOP_K)
    top_w = top_p / jnp.sum(top_p, axis=-1, keepdims=True) * grp_p
    w_in_group = jnp.sum(jax.nn.one_hot(top_idx, MOE_EXPERTS_PER_GROUP, dtype=jnp.float32) * top_w[..., None], axis=1)
    combine = (jax.nn.one_hot(grp_idx[:, 0], MOE_GROUPS, dtype=jnp.float32)[:, :, None] * w_in_group[:, None, :])
    combine = combine.reshape(T, MOE_N_EXPERTS).astype(xt.dtype)
    nblk = T // MOE_TOKEN_BLOCK

    def block(args):
        xb, cb = args
        hg = jnp.einsum('td,edf->tef', xb, w1)
        hu = jnp.einsum('td,edf->tef', xb, w3)
        act = jax.nn.silu(hg) * hu * cb[:, :, None]
        return jnp.einsum('tef,efd->td', act, w2)

    y = lax.map(block, (xt.reshape(nblk, MOE_TOKEN_BLOCK, D), combine.reshape(nblk, MOE_TOKEN_BLOCK, MOE_N_EXPERTS)))
    return y.reshape(B, S, D)


def setup_inputs(seed: int = 0) -> dict:
    key = jax.random.key(seed)
    keys = iter(jax.random.split(key, 64))
    L, H, D = DEPTH, N_HEADS_GROUP, D_MODEL

    def normal(shape, scale):
        return jax.random.normal(next(keys), shape, jnp.float32) * scale

    def gain(shape):
        return 1.0 + normal(shape, 0.02)

    dt = jnp.exp(jax.random.uniform(next(keys), (L, H), jnp.float32, math.log(1e-3), math.log(1e-1)))
    return {
        'x': normal((BATCH, SEQ, D), 1.0),
        'mem': normal((BATCH, MEM_TOKENS, D), 1.0),
        'ln_mix': gain((L, D)),
        'w_in': normal((L, D, IN_COLS), D ** -0.5),
        'w_out': normal((L, MIX_WIDTH, D), MIX_WIDTH ** -0.5),
        'nsa_qk_gain': gain((L, 4, HEAD_DIM)),
        'nsa_cmp_pe': normal((L, 2, NSA_CMP_LEN, HEAD_DIM), 0.02),
        'nsa_cmp_w1': normal((L, 2, NSA_CMP_LEN * HEAD_DIM, NSA_CMP_HIDDEN), (NSA_CMP_LEN * HEAD_DIM) ** -0.5),
        'nsa_cmp_w2': normal((L, 2, NSA_CMP_HIDDEN, HEAD_DIM), NSA_CMP_HIDDEN ** -0.5),
        'gdn_conv': normal((L, GDN_CONV, 3 * GROUP_WIDTH), GDN_CONV ** -0.5),
        'gdn_a_log': jnp.log(jax.random.uniform(next(keys), (L, H), jnp.float32, 1.0, 16.0)),
        'gdn_dt_bias': dt + jnp.log(-jnp.expm1(-dt)),
        'gdn_norm': gain((L, HEAD_DIM)),
        'mlstm_i_bias': normal((L, H), 0.1),
        'mlstm_f_bias': jnp.linspace(3.0, 6.0, H, dtype=jnp.float32)[None, :] + normal((L, H), 0.1),
        'mlstm_norm': gain((L, HEAD_DIM)),
        'diff_qk_gain': gain((L, 2, DIFF_SUB_DIM)),
        'diff_lambda': normal((L, 4, DIFF_SUB_DIM), 0.1),
        'diff_norm': gain((L, HEAD_DIM)),
        'ln_xattn': gain((L, D)),
        'ln_mem': gain((L, D)),
        'xattn_wq': normal((L, D, MEM_HEADS * MEM_HEAD_DIM), D ** -0.5),
        'xattn_wkv': normal((L, D, 2 * MEM_HEADS * MEM_HEAD_DIM), D ** -0.5),
        'xattn_qk_gain': gain((L, 2, MEM_HEAD_DIM)),
        'xattn_wo': normal((L, MEM_HEADS * MEM_HEAD_DIM, D), (MEM_HEADS * MEM_HEAD_DIM) ** -0.5),
        'ln_moe': gain((L, D)),
        'moe_w_group': normal((L, D, MOE_GROUPS), D ** -0.5),
        'moe_b_group': normal((L, MOE_GROUPS), 0.01),
        'moe_w_expert': normal((L, D, MOE_N_EXPERTS), D ** -0.5),
        'moe_b_expert': normal((L, MOE_N_EXPERTS), 0.01),
        'moe_w1': normal((L, MOE_N_EXPERTS, D, MOE_FF), D ** -0.5),
        'moe_w3': normal((L, MOE_N_EXPERTS, D, MOE_FF), D ** -0.5),
        'moe_w2': normal((L, MOE_N_EXPERTS, MOE_FF, D), MOE_FF ** -0.5),
    }


def reference(x, mem, ln_mix, w_in, w_out, nsa_qk_gain, nsa_cmp_pe, nsa_cmp_w1, nsa_cmp_w2,
              gdn_conv, gdn_a_log, gdn_dt_bias, gdn_norm, mlstm_i_bias, mlstm_f_bias, mlstm_norm,
              diff_qk_gain, diff_lambda, diff_norm, ln_xattn, ln_mem, xattn_wq, xattn_wkv,
              xattn_qk_gain, xattn_wo, ln_moe, moe_w_group, moe_b_group, moe_w_expert,
              moe_b_expert, moe_w1, moe_w3, moe_w2):
    S = x.shape[1]
    pos = jnp.arange(S)
    cos_a, sin_a = rope_tables(pos, HEAD_DIM)
    cos_d, sin_d = rope_tables(pos, DIFF_SUB_DIM)
    split_at = np.cumsum(IN_WIDTHS)[:-1].tolist()
    h = x
    for l in range(DEPTH):
        hn = rms_norm(h, ln_mix[l])
        parts = jnp.split(hn @ w_in[l], split_at, axis=-1)
        y_a = nsa_mixer(*parts[0:8], nsa_qk_gain[l], nsa_cmp_pe[l], nsa_cmp_w1[l], nsa_cmp_w2[l], cos_a, sin_a)
        y_b = gdn_mixer(*parts[8:14], gdn_conv[l], gdn_a_log[l], gdn_dt_bias[l], gdn_norm[l])
        y_c = mlstm_mixer(*parts[14:20], mlstm_i_bias[l], mlstm_f_bias[l], mlstm_norm[l])
        lambda_init = 0.8 - 0.6 * math.exp(-0.3 * l)
        y_d = diff_mixer(*parts[20:23], diff_qk_gain[l], diff_lambda[l], diff_norm[l], lambda_init, cos_d, sin_d)
        h = h + jnp.concatenate([y_a, y_b, y_c, y_d], axis=-1) @ w_out[l]
        h = h + memory_cross_attention(rms_norm(h, ln_xattn[l]), rms_norm(mem, ln_mem[l]),
                                       xattn_wq[l], xattn_wkv[l], xattn_qk_gain[l], xattn_wo[l])
        h = h + hierarchical_moe(rms_norm(h, ln_moe[l]), moe_w_group[l], moe_b_group[l], moe_w_expert[l],
                                 moe_b_expert[l], moe_w1[l], moe_w3[l], moe_w2[l])
    return h
```

```cpp
#include <hip/hip_runtime.h>
#include <stdint.h>
#include <stdio.h>

#ifndef MK_SINGLE
#define MK_SINGLE 1
#endif

#define DI __device__ __forceinline__
#ifndef PH_MASK
#define PH_MASK 0xFFFFFFFFu
#endif
#define EN(k) ((MASK >> (k)) & 1u)
#ifndef REP_PH
#define REP_PH -1
#endif
#ifndef EXPT
#define EXPT 0
#endif
#ifndef REP_L
#define REP_L -1
#endif
#define REPN(k) (((k) == REP_PH && (REP_L < 0 || l == REP_L)) ? 2 : 1)
#ifndef SUB_MASK
#define SUB_MASK 0xFu
#endif
#define SUB(k) (((SUB_MASK >> (k)) & 1u) || rr > 0 || REP_PH < 0)
#define LAS __attribute__((address_space(3)))
typedef unsigned short bf16;
typedef short bf16x8 __attribute__((ext_vector_type(8)));
typedef short s16x4 __attribute__((ext_vector_type(4)));
typedef float f32x2 __attribute__((ext_vector_type(2)));
typedef float f32x4 __attribute__((ext_vector_type(4)));
typedef float f32x16 __attribute__((ext_vector_type(16)));
typedef unsigned u32x2 __attribute__((ext_vector_type(2)));
typedef unsigned u32x4 __attribute__((ext_vector_type(4)));
typedef __bf16 hbf2 __attribute__((ext_vector_type(2)));

constexpr int NB = 8, SEQ = 4096, T = NB * SEQ, DM = 1024, PC = 3328;
constexpr int A_Q = 0, A_KC = 256, A_VC = 320, A_KS = 384, A_VS = 448, A_KW = 512, A_VW = 576;
constexpr int B_Q = 640, B_K = 896, B_V = 1152, B_Z = 1408;
constexpr int C_Q = 1664, C_K = 1792, C_V = 1920, C_O = 2176;
constexpr int D_Q = 2432, D_K = 2688, D_V = 2944, SMC = 3200;
constexpr float EPS = 1e-6f;
constexpr float LOG2E = 1.4426950408889634f;
constexpr float QSCALE = 0.125f * LOG2E;
constexpr float DSCALE = 0.17677669529663687f * LOG2E;
constexpr int NTHREADS = 512, NWAVES = 8;
constexpr int NSLOT = 73728;

constexpr size_t MiB = 1u << 20, KiB = 1u << 10;
constexpr size_t WS_CTL = 0, CTL_ZERO_BYTES = 64 * KiB;
constexpr size_t WS_WIN = 1 * MiB;
constexpr size_t WIN_L = (size_t)PC * DM * 2;
constexpr size_t WS_WOUT = 14 * MiB;
constexpr size_t WS_CW1 = 18 * MiB;
constexpr size_t WS_CW2 = 22 * MiB;
constexpr size_t WS_CB1 = 22 * MiB + 256 * KiB;
constexpr size_t WS_ROPE = 22 * MiB + 512 * KiB;
constexpr size_t WS_XWQ = 24 * MiB;
constexpr size_t WS_XWKV = 25 * MiB;
constexpr size_t WS_XWO = 27 * MiB;
constexpr size_t WS_WRT = 28 * MiB;
constexpr size_t WS_MEMN = 446 * MiB;
constexpr size_t WS_MW13 = 33 * MiB;
constexpr size_t WS_MW2 = 65 * MiB;
constexpr size_t WS_HN = 81 * MiB;
constexpr size_t WS_PROJ = 145 * MiB;
constexpr size_t WS_KCR = 353 * MiB;
constexpr size_t WS_VCR = 357 * MiB + 512 * KiB;
constexpr size_t WS_HID = 362 * MiB;
constexpr size_t WS_KCL = 364 * MiB;
constexpr size_t WS_VCL = 364 * MiB + 512 * KiB;
constexpr size_t WS_RES = 365 * MiB;
constexpr size_t OUT_GW = 0;
constexpr size_t WS_GL = 445 * MiB;
constexpr size_t OUT_CLOC = 80 * MiB;
constexpr size_t OUT_CIN = 96 * MiB;
constexpr size_t WS_NLOC = 478 * MiB;
constexpr size_t WS_NIN = 478 * MiB + 256 * KiB;
constexpr size_t WS_MLOC = 478 * MiB + 512 * KiB;
constexpr size_t WS_BLAST = WS_MLOC + 8 * KiB;
constexpr size_t WS_MIN = WS_MLOC + 16 * KiB;
constexpr size_t WS_TOKE = 479 * MiB;
constexpr size_t WS_TOKW = WS_TOKE + 256 * KiB;
constexpr size_t WS_TOKS = WS_TOKW + 256 * KiB;
constexpr size_t WS_SLOTTOK = WS_TOKS + 256 * KiB;
constexpr size_t WS_MCNT = WS_SLOTTOK + 320 * KiB;
constexpr size_t WS_BLKCNT = WS_MCNT + 1 * KiB;
constexpr size_t WS_KCN = 480 * MiB + 256 * KiB;
constexpr size_t WS_VCN = 480 * MiB + 512 * KiB;
constexpr size_t WS_RS = 480 * MiB + 768 * KiB;
constexpr size_t WS_END = 481 * MiB;
constexpr size_t WS_XQ = WS_PROJ;
constexpr size_t WS_XAO = WS_PROJ + 16 * MiB;
constexpr size_t WS_XKV = WS_PROJ + 32 * MiB;
constexpr size_t WS_ACT = WS_PROJ;
constexpr size_t WS_YMOE = WS_PROJ + 40 * MiB;
constexpr int CW_BAR = 1024;

constexpr int LDS_BYTES = 163840;
constexpr int LDS_MISC = 131072;
constexpr int LDS_GOFF = 131072 + 2048;

DI unsigned pk2(float lo, float hi) { f32x2 v = {lo, hi}; hbf2 b = __builtin_convertvector(v, hbf2); return __builtin_bit_cast(unsigned, b); }
DI bf16 f2bf(float f) { return (bf16)(pk2(f, 0.f) & 0xffffu); }
DI u32x4 f8_to_bf(const float (&x)[8]) { u32x4 r; r.x = pk2(x[0], x[1]); r.y = pk2(x[2], x[3]); r.z = pk2(x[4], x[5]); r.w = pk2(x[6], x[7]); return r; }
DI float bf2f(bf16 b) { return __builtin_bit_cast(float, ((unsigned)b) << 16); }
DI float bflo(unsigned u) { return __builtin_bit_cast(float, u << 16); }
DI float bfhi(unsigned u) { return __builtin_bit_cast(float, u & 0xffff0000u); }
DI float ex2(float x) { return __builtin_amdgcn_exp2f(x); }
DI float fexp(float x) { return __builtin_amdgcn_exp2f(x * LOG2E); }
DI float flog(float x) { return __builtin_amdgcn_logf(x) * 0.6931471805599453f; }
DI float sigm(float x) { return 1.f / (1.f + fexp(-x)); }
DI float silu(float x) { return x / (1.f + fexp(-x)); }
DI float tanh_(float x) { const float e = fexp(2.f * x); return 1.f - 2.f / (e + 1.f); }
DI float softplus_(float x) { return fmaxf(x, 0.f) + flog(1.f + fexp(-fabsf(x))); }
DI float gelu_tanh(float x) { const float u = 0.7978845608028654f * (x + 0.044715f * x * x * x); return 0.5f * x * (1.f + tanh_(u)); }
DI float rsq(float x) { return 1.f / sqrtf(x); }
DI int lane_op() { int l = (int)__lane_id(); asm volatile("" : "+v"(l)); return l; }
DI int shx(int v, int m) { return __builtin_amdgcn_ds_bpermute((lane_op() ^ m) << 2, v); }
DI float shx(float v, int m) { return __builtin_bit_cast(float, shx(__builtin_bit_cast(int, v), m)); }
DI int shu(int v, int o) { const int l = lane_op(); return __builtin_amdgcn_ds_bpermute((l >= o ? l - o : l) << 2, v); }
DI float shu(float v, int o) { return __builtin_bit_cast(float, shu(__builtin_bit_cast(int, v), o)); }
DI float wsum(float v) {
#pragma unroll
    for (int o = 1; o < 64; o <<= 1) v += shx(v, o);
    return v;
}
DI float wmax(float v) {
#pragma unroll
    for (int o = 1; o < 64; o <<= 1) v = fmaxf(v, shx(v, o));
    return v;
}
DI int crow(int r, int hi) { return (r & 3) + 8 * (r >> 2) + 4 * hi; }
#define CR(r) (((r) & 3) + 8 * ((r) >> 2))
#define MFMA32(a, b, c) __builtin_amdgcn_mfma_f32_32x32x16_bf16((a), (b), (c), 0, 0, 0)
#define LDS_WAIT() asm volatile("s_waitcnt lgkmcnt(0)" ::: "memory")

#define XB_TMO      128
#define XB_XCNT(j)  (256  + 64 * (j))
#define XB_XSUB(j)  (1280 + 64 * (j))
#define XB_XGEN(j)  (2304 + 64 * (j))
#define XB_TOP      3328
#define XB_TOPGEN   3392
#define XCD_BAR_WORDS 3456
#define XB_SPIN_CAP (1u << 21)

DI unsigned xb_ld(unsigned* p)              { return __hip_atomic_load(p, __ATOMIC_RELAXED, __HIP_MEMORY_SCOPE_AGENT); }
DI unsigned xb_add(unsigned* p, unsigned v) { return __hip_atomic_fetch_add(p, v, __ATOMIC_RELAXED, __HIP_MEMORY_SCOPE_AGENT); }
DI unsigned xb_xcc_id() { return (unsigned)__builtin_amdgcn_s_getreg((3 << 11) | 20) & 0xFu; }
#define XB_SPIN(cond, bar) do { unsigned _sp = 0; while (cond) { __builtin_amdgcn_s_sleep(1); \
    if ((++_sp & 255u) == 0u) { if (xb_ld(&(bar)[XB_TMO])) break; if (_sp > XB_SPIN_CAP) { atomicAdd(&(bar)[XB_TMO], 1u); break; } } } } while (0)

struct XcdBarrier { unsigned* bar; unsigned x; volatile LAS unsigned* st; };

DI XcdBarrier xcd_barrier_post(unsigned* bar, volatile LAS unsigned* st) {
    XcdBarrier b; b.bar = bar; b.x = xb_xcc_id(); b.st = st;
    if (threadIdx.x == 0) (void)xb_add(&bar[XB_XCNT(b.x)], 1u);
    return b;
}
DI void xcd_barrier_complete(unsigned* bar, unsigned x, unsigned& nloc, unsigned& nx) {
    const unsigned G = gridDim.x * gridDim.y * gridDim.z;
    unsigned sum, cnt, mine, sp = 0u;
    for (;;) {
        sum = 0u; cnt = 0u; mine = 0u;
#pragma unroll
        for (unsigned j = 0; j < 16; ++j) { const unsigned c = xb_ld(&bar[XB_XCNT(j)]); sum += c; cnt += (c > 0u) ? 1u : 0u; }
        if (sum == G) break;
        __builtin_amdgcn_s_sleep(1);
        if ((++sp & 255u) == 0u) { if (xb_ld(&bar[XB_TMO])) break; if (sp > XB_SPIN_CAP) { atomicAdd(&bar[XB_TMO], 1u); break; } }
    }
    mine = xb_ld(&bar[XB_XCNT(x)]);
    nloc = mine > 0u ? mine : 1u; nx = cnt > 0u ? cnt : 1u;
}
DI void xcd_barrier(const XcdBarrier& b) {
    asm volatile("s_waitcnt vmcnt(0)" ::: "memory");
    __syncthreads();
    if (threadIdx.x == 0) {
        unsigned* bar = b.bar;
        __builtin_amdgcn_s_waitcnt(0);
        unsigned nloc = b.st[0], nx = b.st[1];
        if (nloc == 0u) { xcd_barrier_complete(bar, b.x, nloc, nx); b.st[0] = nloc; b.st[1] = nx; }
        const unsigned old = xb_add(&bar[XB_XSUB(b.x)], 1u);
        const unsigned gen = old / nloc;
        if (old + 1u == (gen + 1u) * nloc) {
            __builtin_amdgcn_fence(__ATOMIC_RELEASE, "agent");
            asm volatile("s_waitcnt vmcnt(0)" ::: "memory");
            const unsigned og = xb_add(&bar[XB_TOP], 1u);
            const unsigned tg = og / nx;
            if (og + 1u == (tg + 1u) * nx) xb_add(&bar[XB_TOPGEN], 1u);
            else XB_SPIN(xb_ld(&bar[XB_TOPGEN]) == tg, bar);
            __builtin_amdgcn_fence(__ATOMIC_ACQUIRE, "agent");
            xb_add(&bar[XB_XGEN(b.x)], 1u);
            asm volatile("s_waitcnt vmcnt(0)" ::: "memory");
        } else {
            XB_SPIN(xb_ld(&bar[XB_XGEN(b.x)]) == gen, bar);
            __builtin_amdgcn_fence(__ATOMIC_ACQUIRE, "agent");
            asm volatile("s_waitcnt vmcnt(0)" ::: "memory");
        }
    }
    __syncthreads();
}

namespace pg8 {
typedef float f32x4 __attribute__((ext_vector_type(4)));
constexpr int BM = 256, BK = 64, HALF = 128, HTB = HALF * BK * 2, NXCD = 8, WGM = 8;
DI int lds_byte(int r, int c) { const int st = (r >> 4) * 2 + (c >> 5), rr = r & 15, cc = c & 31, ob = rr * 64 + cc * 2; return st * 1024 + (ob ^ (((ob >> 9) & 1) << 5)); }
DI void stage_rc(int b, int& R, int& C) { const int st = b / 1024, sb = b % 1024, swz = sb ^ (((sb >> 9) & 1) << 5); R = (st >> 1) * 16 + swz / 64; C = (st & 1) * 32 + (swz % 64) / 2; }
DI int perm32(int rho) { const int n = rho >> 4, i = rho & 15; return 8 * (i >> 2) + 4 * n + (i & 3); }

struct Unit { int pm, pn, kind, e; };
struct Gemm { const bf16* A; const bf16* Bt; int lda, ldb, K; };

struct StaticOrder {
    int nM, nN, nwg, G, c;
    DI void init(int M, int N, int G_, int c_) { nM = M / BM; nN = N / BM; nwg = nM * nN; G = G_; c = c_; }
    DI bool next(int i, Unit& u) const {
        const long L = (long)i * G + c; if (L >= nwg) return false;
        int wgid = (int)L; { const int q = nwg / NXCD, r = nwg % NXCD, xcd = wgid % NXCD, off = wgid / NXCD; wgid = (xcd < r ? xcd * (q + 1) : r * (q + 1) + (xcd - r) * q) + off; }
        const int nig = WGM * nN, gid = wgid / nig, fm = gid * WGM, gsz = (nM - fm) < WGM ? (nM - fm) : WGM;
        u.pm = fm + ((wgid % nig) % gsz); u.pn = (wgid % nig) / gsz; u.kind = 0; u.e = 0; return true;
    }
    DI const char* abase(const Gemm& g, const Unit& u) const { return (const char*)g.A + (size_t)u.pm * BM * g.lda * 2; }
    DI const char* bbase(const Gemm& g, const Unit& u) const { return (const char*)g.Bt + (size_t)u.pn * BM * g.ldb * 2; }
    DI int arow(const Unit&, int r) const { return r; }
};

template <class Epi, class Sched, bool GATHER>
DI void gemm_phase(LAS unsigned char* lds, const Gemm g, const Sched& S, const Epi& E) {
    int tid = threadIdx.x; asm volatile("" : "+v"(tid));
    const int wid = __builtin_amdgcn_readfirstlane(tid >> 6), lane = tid & 63, wr = wid >> 2, wc = wid & 3, fr = lane & 15, fq = lane >> 4;
    const int K = g.K, nt = K / BK;
    unsigned voffA[2], voffB[2];
#pragma unroll
    for (int i = 0; i < 2; ++i) { int R, C; stage_rc(tid * 16 + i * 8192, R, C); const int Rb = (R & ~31) + perm32(R & 31);
        voffA[i] = (unsigned)(R * g.lda + C) * 2u; voffB[i] = (unsigned)(Rb * g.ldb + C) * 2u; }
    const size_t kstep = (size_t)(BK * 2);
    const size_t hstepA = (size_t)HALF * g.lda * 2, hstepB = (size_t)HALF * g.ldb * 2;
    const unsigned ldsw = (unsigned)wid * 1024u;
    const int aoff = lds_byte(wr * 64 + fr, fq * 8), boff = lds_byte(wc * 32 + fr, fq * 8);
#define PG8_SA(b, h) (((b) * 2 + (h)) * HTB)
#define PG8_SB(b, h) ((4 + (b) * 2 + (h)) * HTB)
#define PG8_GLDS(bufoff, p0, p1) do { \
        __builtin_amdgcn_global_load_lds((const unsigned*)(p0), (LAS unsigned*)(lds + (bufoff) + ldsw), 16, 0, 0); \
        __builtin_amdgcn_global_load_lds((const unsigned*)(p1), (LAS unsigned*)(lds + (bufoff) + ldsw + 8192), 16, 0, 0); } while (0)
#define PG8_STAGEB(bufoff, gbase) PG8_GLDS(bufoff, (const char*)(gbase) + voffB[0], (const char*)(gbase) + voffB[1])
#define PG8_STAGEA(bufoff, nx, h, koff) do { if constexpr (GATHER) { \
            const int _par = ((nx) ? ui + 1 : ui) & 1; const unsigned _v0 = goff[(_par * 4 + (h) * 2) * 512], _v1 = goff[(_par * 4 + (h) * 2 + 1) * 512]; \
            PG8_GLDS(bufoff, (const char*)g.A + (koff) + _v0, (const char*)g.A + (koff) + _v1); \
        } else { const char* _b = ((nx) ? nA : cA) + (size_t)(h) * hstepA + (koff); PG8_GLDS(bufoff, _b + voffA[0], _b + voffA[1]); } } while (0)
#define PG8_LDA(dst, b, h) do { _Pragma("unroll") for (int m = 0; m < 4; ++m) _Pragma("unroll") for (int k = 0; k < 2; ++k) dst[m][k] = *(const LAS bf16x8*)(lds + PG8_SA(b, h) + aoff + m * 2048 + k * 1024); } while (0)
#define PG8_LDB(dst, b, h) do { _Pragma("unroll") for (int n = 0; n < 2; ++n) _Pragma("unroll") for (int k = 0; k < 2; ++k) dst[n][k] = *(const LAS bf16x8*)(lds + PG8_SB(b, h) + boff + n * 2048 + k * 1024); } while (0)
#define PG8_MMA(ai, bj, At, Bt) do { __builtin_amdgcn_s_setprio(1); _Pragma("unroll") for (int m = 0; m < 4; ++m) _Pragma("unroll") for (int n = 0; n < 2; ++n) _Pragma("unroll") for (int k = 0; k < 2; ++k) \
        acc[ai][bj][m][n] = __builtin_amdgcn_mfma_f32_16x16x32_bf16(Bt[n][k], At[m][k], acc[ai][bj][m][n], 0, 0, 0); __builtin_amdgcn_s_setprio(0); } while (0)
#define PG8_WAIT_V(n) asm volatile("s_waitcnt vmcnt(" #n ")" ::: "memory")
#define PG8_WAIT_L(n) asm volatile("s_waitcnt lgkmcnt(" #n ")" ::: "memory")
#define PG8_BAR __builtin_amdgcn_s_barrier()
#define PG8_SCHED __builtin_amdgcn_sched_barrier(0)
    Unit cur, nxt; int ui = 0;
    if (!S.next(0, cur)) return;
    f32x4 acc[2][2][4][2];
#pragma unroll
    for (int a = 0; a < 2; ++a)
#pragma unroll
        for (int b = 0; b < 2; ++b)
#pragma unroll
            for (int m = 0; m < 4; ++m)
#pragma unroll
                for (int n = 0; n < 2; ++n) acc[a][b][m][n] = (f32x4){0.f, 0.f, 0.f, 0.f};
    bf16x8 At[4][2], B0[2][2], B1[2][2];
    const char* cA = S.abase(g, cur); const char* cB = S.bbase(g, cur);
    const char* nA = cA;
    LAS unsigned* goff = (LAS unsigned*)(lds + LDS_GOFF) + tid;
#define PG8_GFILL(par, uu) do { _Pragma("unroll") for (int h = 0; h < 2; ++h) _Pragma("unroll") for (int i = 0; i < 2; ++i) { int R, C; stage_rc(tid * 16 + i * 8192, R, C); \
        goff[((par) * 4 + h * 2 + i) * 512] = (unsigned)S.arow(uu, h * HALF + R) * (unsigned)(g.lda * 2) + (unsigned)(C * 2); } } while (0)
    if constexpr (GATHER) { PG8_GFILL(0, cur); }
    PG8_STAGEB(PG8_SB(0, 0), cB); PG8_STAGEB(PG8_SB(0, 1), cB + hstepB); PG8_STAGEA(PG8_SA(0, 0), false, 0, (size_t)0); PG8_STAGEA(PG8_SA(0, 1), false, 1, (size_t)0);
    if (wr == 1) PG8_BAR;
    PG8_WAIT_V(2); PG8_BAR;
    PG8_STAGEB(PG8_SB(1, 0), cB + kstep); PG8_STAGEA(PG8_SA(1, 0), false, 0, kstep); PG8_STAGEB(PG8_SB(1, 1), cB + hstepB + kstep);
    PG8_WAIT_V(6); PG8_BAR;
    for (;;) {
        const bool has_next = S.next(ui + 1, nxt);
        nA = has_next ? S.abase(g, nxt) : cA; const char* nB = has_next ? S.bbase(g, nxt) : cB;
        if constexpr (GATHER) { if (has_next) PG8_GFILL((ui + 1) & 1, nxt); else PG8_GFILL((ui + 1) & 1, cur); }
#pragma unroll 1
        for (int t = 0; t < nt; t += 2) {
            const bool last = (t == nt - 2);
            const size_t k1 = (size_t)(t + 1) * kstep;
            const size_t k2 = last ? (size_t)0 : (size_t)(t + 2) * kstep, k3 = k2 + kstep;
            const char* b2 = last ? nB : cB + (size_t)(t + 2) * kstep; const char* b3 = b2 + kstep;
            PG8_LDB(B0, 0, 0); PG8_LDB(B1, 0, 1); PG8_SCHED; PG8_LDA(At, 0, 0); PG8_STAGEA(PG8_SA(1, 1), false, 1, k1);
            PG8_WAIT_V(8); PG8_WAIT_L(0); PG8_BAR; PG8_MMA(0, 0, At, B0); PG8_MMA(0, 1, At, B1); PG8_BAR; PG8_SCHED;
            PG8_LDA(At, 0, 1); PG8_STAGEB(PG8_SB(0, 0), b2); PG8_STAGEB(PG8_SB(0, 1), b2 + hstepB); PG8_STAGEA(PG8_SA(0, 0), last, 0, k2);
            PG8_WAIT_V(8); PG8_WAIT_L(0); PG8_BAR; PG8_MMA(1, 0, At, B0); PG8_MMA(1, 1, At, B1); PG8_BAR; PG8_SCHED;
            PG8_LDB(B0, 1, 0); PG8_LDB(B1, 1, 1); PG8_SCHED; PG8_LDA(At, 1, 0); PG8_STAGEA(PG8_SA(0, 1), last, 1, k2);
            PG8_WAIT_V(8); PG8_WAIT_L(0); PG8_BAR; PG8_MMA(0, 0, At, B0); PG8_MMA(0, 1, At, B1); PG8_BAR; PG8_SCHED;
            PG8_LDA(At, 1, 1); PG8_STAGEB(PG8_SB(1, 0), b3); PG8_STAGEB(PG8_SB(1, 1), b3 + hstepB); PG8_STAGEA(PG8_SA(1, 0), last, 0, k3);
            PG8_WAIT_V(8); PG8_WAIT_L(0); PG8_BAR; PG8_MMA(1, 0, At, B0); PG8_MMA(1, 1, At, B1); PG8_BAR; PG8_SCHED;
        }
        if (wr == 0) PG8_BAR;
        E(acc, cur, wr, wc, fr, fq);
        if (!has_next) break;
#pragma unroll
        for (int a = 0; a < 2; ++a)
#pragma unroll
            for (int b = 0; b < 2; ++b)
#pragma unroll
                for (int m = 0; m < 4; ++m)
#pragma unroll
                    for (int n = 0; n < 2; ++n) acc[a][b][m][n] = (f32x4){0.f, 0.f, 0.f, 0.f};
        cur = nxt; cA = nA; cB = nB; ++ui;
        if (wr == 1) PG8_BAR;
    }
    PG8_WAIT_V(0);
    PG8_BAR;
#undef PG8_SA
#undef PG8_SB
#undef PG8_GLDS
#undef PG8_STAGEB
#undef PG8_STAGEA
#undef PG8_GFILL
#undef PG8_LDA
#undef PG8_LDB
#undef PG8_MMA
#undef PG8_WAIT_V
#undef PG8_WAIT_L
#undef PG8_BAR
#undef PG8_SCHED
}

#define EPI_LOOP_BEGIN \
    const int row0 = u.pm * BM + wr * 64 + fr; const int colb = wc * 32 + 8 * fq; \
    _Pragma("unroll") for (int ai = 0; ai < 2; ++ai) _Pragma("unroll") for (int m = 0; m < 4; ++m) { const int row = row0 + ai * HALF + m * 16; \
    _Pragma("unroll") for (int bj = 0; bj < 2; ++bj) { const int colt = bj * HALF + colb; const f32x4 v0 = acc[ai][bj][m][0], v1 = acc[ai][bj][m][1];
#define EPI_LOOP_END } }

struct EpiBf16 {
    bf16* O; int ldc;
    DI void operator()(const f32x4 (&acc)[2][2][4][2], const Unit& u, int wr, int wc, int fr, int fq) const {
        EPI_LOOP_BEGIN
            u32x4 w; w.x = pk2(v0[0], v0[1]); w.y = pk2(v0[2], v0[3]); w.z = pk2(v1[0], v1[1]); w.w = pk2(v1[2], v1[3]);
            *(u32x4*)(O + (size_t)row * ldc + u.pn * BM + colt) = w;
        EPI_LOOP_END
    }
};
struct EpiResid {
    const float* srcf; const bf16* srcb; bf16* res; float sc;
    DI void operator()(const f32x4 (&acc)[2][2][4][2], const Unit& u, int wr, int wc, int fr, int fq) const {
        EPI_LOOP_BEGIN
            const size_t o = (size_t)row * DM + u.pn * BM + colt;
            f32x4 s0, s1;
            if (srcf) { s0 = *(const f32x4*)(srcf + o); s1 = *(const f32x4*)(srcf + o + 4); }
            else { const u32x4 w = *(const u32x4*)(srcb + o); s0 = (f32x4){bflo(w.x), bfhi(w.x), bflo(w.y), bfhi(w.y)}; s1 = (f32x4){bflo(w.z), bfhi(w.z), bflo(w.w), bfhi(w.w)}; }
            s0 = s0 + v0 * sc; s1 = s1 + v1 * sc;
            u32x4 w; w.x = pk2(s0[0], s0[1]); w.y = pk2(s0[2], s0[3]); w.z = pk2(s1[0], s1[1]); w.w = pk2(s1[2], s1[3]);
            *(u32x4*)(res + o) = w;
        EPI_LOOP_END
    }
};
struct EpiCmp1 {
    bf16* hid;
    DI void operator()(const f32x4 (&acc)[2][2][4][2], const Unit& u, int wr, int wc, int fr, int fq) const {
        EPI_LOOP_BEGIN
            u32x4 w; w.x = pk2(v0[0], v0[1]); w.y = pk2(v0[2], v0[3]); w.z = pk2(v1[0], v1[1]); w.w = pk2(v1[2], v1[3]);
            *(u32x4*)(hid + (size_t)u.kind * 2048 * 256 + (size_t)row * 256 + colt) = w;
        EPI_LOOP_END
    }
};
struct EpiCmp2 {
    float* kcl; float* vcl;
    DI void operator()(const f32x4 (&acc)[2][2][4][2], const Unit& u, int wr, int wc, int fr, int fq) const {
        float* dst = u.kind ? vcl : kcl;
        EPI_LOOP_BEGIN
            if (colt < 64) { const bool z = (row & 255) == 255; const f32x4 zz = {0.f, 0.f, 0.f, 0.f};
                *(f32x4*)(dst + (size_t)row * 64 + colt) = z ? zz : v0; *(f32x4*)(dst + (size_t)row * 64 + colt + 4) = z ? zz : v1; }
        EPI_LOOP_END
    }
};
struct EpiXqkv {
    bf16* xq; bf16* xkv; const LAS float* rstab;
    DI void operator()(const f32x4 (&acc)[2][2][4][2], const Unit& u, int wr, int wc, int fr, int fq) const {
        bf16* dst = u.kind ? xkv : xq; const int ldc = u.kind ? 512 : 256;
        EPI_LOOP_BEGIN
            const float rs = u.kind ? 1.f : rstab[u.e * BM + row - u.pm * BM];
            u32x4 w; w.x = pk2(v0[0] * rs, v0[1] * rs); w.y = pk2(v0[2] * rs, v0[3] * rs); w.z = pk2(v1[0] * rs, v1[1] * rs); w.w = pk2(v1[2] * rs, v1[3] * rs);
            *(u32x4*)(dst + (size_t)row * ldc + u.pn * BM + colt) = w;
        EPI_LOOP_END
    }
};
struct EpiSwiglu {
    bf16* act; const int* slottok; const float* rsv;
    DI void operator()(const f32x4 (&acc)[2][2][4][2], const Unit& u, int wr, int wc, int fr, int fq) const {
        const int row0 = u.pm * BM + wr * 64 + fr; const int colb = wc * 32 + 8 * fq;
#pragma unroll
        for (int ai = 0; ai < 2; ++ai)
#pragma unroll
            for (int m = 0; m < 4; ++m) { const int row = row0 + ai * HALF + m * 16; const float rs = rsv[slottok[row]];
                const f32x4 g0 = acc[ai][0][m][0] * rs, g1 = acc[ai][0][m][1] * rs, u0 = acc[ai][1][m][0] * rs, u1 = acc[ai][1][m][1] * rs;
                u32x4 w; w.x = pk2(silu(g0[0]) * u0[0], silu(g0[1]) * u0[1]); w.y = pk2(silu(g0[2]) * u0[2], silu(g0[3]) * u0[3]);
                w.z = pk2(silu(g1[0]) * u1[0], silu(g1[1]) * u1[1]); w.w = pk2(silu(g1[2]) * u1[2], silu(g1[3]) * u1[3]);
                *(u32x4*)(act + (size_t)row * 256 + u.pn * 128 + colb) = w; }
    }
};
}

struct Args { const float* in[33]; float* out; unsigned char* ws; int l_lo, l_hi, ph_lo, ph_hi, pro, fin; };

struct Ctx {
    const float* const __attribute__((address_space(4)))* in; float* out; unsigned char* ws; LAS unsigned char* lds;
    int tid, lane, wave, G, blk, gw, ngw, l;
    DI bf16* wsb(size_t off) const { return (bf16*)(ws + off); }
    DI float* wsf(size_t off) const { return (float*)(ws + off); }
    DI int* wsi(size_t off) const { return (int*)(ws + off); }
    DI bf16* ob16(size_t off) const { return (bf16*)((unsigned char*)out + off); }
    DI float* of32(size_t off) const { return (float*)((unsigned char*)out + off); }
};

DI int win_src(int n) {
    if (n < 640) return n;
    if (n < 1408) return n + 12;
    if (n < 2176) return n + 20;
    if (n < 3200) return n + 28;
    if (n < 3212) return n - 3200 + 640;
    if (n < 3220) return n - 3212 + 1420;
    if (n < 3228) return n - 3220 + 2196;
    return -1;
}
DI void transpose_item(const float* W, int K, int Nsrc, bf16* WT, LAS float* scr, int kb, int nb, int lane, int sc, const float* kgain = nullptr) {
    const int k0 = 64 * kb, n0 = 32 * nb;
    float v[32];
#pragma unroll
    for (int i = 0; i < 32; ++i) { const int kk = 2 * i + (lane >> 5); v[i] = (sc >= 0) ? W[(size_t)(k0 + kk) * Nsrc + sc] : 0.f; }
    if (kgain) {
#pragma unroll
        for (int i = 0; i < 32; ++i) v[i] *= kgain[k0 + 2 * i + (lane >> 5)]; }
#pragma unroll
    for (int i = 0; i < 32; ++i) { const int kk = 2 * i + (lane >> 5); scr[kk * 33 + (lane & 31)] = v[i]; }
    LDS_WAIT();
    const int c = lane & 7;
#pragma unroll
    for (int j = 0; j < 4; ++j) { const int n = (lane >> 3) + 8 * j; const LAS float* s = scr + (8 * c) * 33 + n;
        u32x4 o; o.x = pk2(s[0 * 33], s[1 * 33]); o.y = pk2(s[2 * 33], s[3 * 33]); o.z = pk2(s[4 * 33], s[5 * 33]); o.w = pk2(s[6 * 33], s[7 * 33]);
        *(u32x4*)(WT + (size_t)(n0 + n) * K + k0 + 8 * c) = o; }
    LDS_WAIT();
}

DI void row_load(const float* p, int lane, f32x4 (&v)[4]) {
#pragma unroll
    for (int j = 0; j < 4; ++j) v[j] = *(const f32x4*)(p + 4 * lane + 256 * j);
}
DI void row_load_bf(const bf16* p, int lane, f32x4 (&v)[4]) {
#pragma unroll
    for (int j = 0; j < 4; ++j) { const u32x2 w = *(const u32x2*)(p + 4 * lane + 256 * j); v[j] = (f32x4){bflo(w.x), bfhi(w.x), bflo(w.y), bfhi(w.y)}; }
}
DI void row_store_bf(bf16* p, int lane, const f32x4 (&v)[4]) {
#pragma unroll
    for (int j = 0; j < 4; ++j) { u32x2 w; w.x = pk2(v[j][0], v[j][1]); w.y = pk2(v[j][2], v[j][3]); *(u32x2*)(p + 4 * lane + 256 * j) = w; }
}
DI float row_ss(const f32x4 (&v)[4]) { float s = 0.f;
#pragma unroll
    for (int j = 0; j < 4; ++j) s += (v[j][0] * v[j][0] + v[j][1] * v[j][1]) + (v[j][2] * v[j][2] + v[j][3] * v[j][3]);
    return wsum(s); }
DI void row_norm_store(const f32x4 (&v)[4], float rs, const float* g, bf16* o, int lane) {
#pragma unroll
    for (int j = 0; j < 4; ++j) { const f32x4 gg = *(const f32x4*)(g + 4 * lane + 256 * j);
        u32x2 w; w.x = pk2(v[j][0] * rs * gg[0], v[j][1] * rs * gg[1]); w.y = pk2(v[j][2] * rs * gg[2], v[j][3] * rs * gg[3]);
        *(u32x2*)(o + 4 * lane + 256 * j) = w; }
}
DI void phase_prologue(const Ctx& c) {
    LAS float* scr = (LAS float*)(c.lds + c.wave * 16384);
    constexpr int I_WIN = 16 * 104, I_WOUT = 16 * 32, I_XQ = 16 * 8, I_XKV = 16 * 16, I_XO = 4 * 32, I_C1 = 32 * 8, I_C2 = 2 * 8;
    constexpr int PER_L = I_WIN + I_WOUT + I_XQ + I_XKV + I_XO + 2 * I_C1 + 2 * I_C2;
    for (int it = c.gw; it < 2 * PER_L; it += c.ngw) {
        const int l = it / PER_L; int r = it % PER_L; const int ln = c.lane & 31;
        if (r < I_WIN) { const int kb = r / 104, nb = r % 104; transpose_item(c.in[3] + (size_t)l * DM * 3228, DM, 3228, c.wsb(WS_WIN + l * WIN_L), scr, kb, nb, c.lane, win_src(32 * nb + ln)); continue; } r -= I_WIN;
        if (r < I_WOUT) { const int kb = r / 32, nb = r % 32; transpose_item(c.in[4] + (size_t)l * DM * DM, DM, DM, c.wsb(WS_WOUT + (size_t)l * 2 * MiB), scr, kb, nb, c.lane, 32 * nb + ln); continue; } r -= I_WOUT;
        if (r < I_XQ) { const int kb = r / 8, nb = r % 8; transpose_item(c.in[21] + (size_t)l * DM * 256, DM, 256, c.wsb(WS_XWQ + (size_t)l * 512 * KiB), scr, kb, nb, c.lane, 32 * nb + ln, c.in[19] + (size_t)l * DM); continue; } r -= I_XQ;
        if (r < I_XKV) { const int kb = r / 16, nb = r % 16; transpose_item(c.in[22] + (size_t)l * DM * 512, DM, 512, c.wsb(WS_XWKV + (size_t)l * MiB), scr, kb, nb, c.lane, 32 * nb + ln); continue; } r -= I_XKV;
        if (r < I_XO) { const int kb = r / 32, nb = r % 32; transpose_item(c.in[24] + (size_t)l * 256 * DM, 256, DM, c.wsb(WS_XWO + (size_t)l * 512 * KiB), scr, kb, nb, c.lane, 32 * nb + ln); continue; } r -= I_XO;
        if (r < 2 * I_C1) { const int j = r / I_C1, q = r % I_C1, kb = q / 8, nb = q % 8; const int n = 32 * nb + ln;
            transpose_item(c.in[7] + (size_t)(l * 2 + j) * 2048 * 128, 2048, 128, c.wsb(WS_CW1 + (size_t)(l * 2 + j) * MiB), scr, kb, nb, c.lane, n < 128 ? n : -1); continue; } r -= 2 * I_C1;
        { const int j = r / I_C2, q = r % I_C2, kb = q / 8, nb = q % 8; const int n = 32 * nb + ln;
            transpose_item(c.in[8] + (size_t)(l * 2 + j) * 128 * 64, 128, 64, c.wsb(WS_CW2 + (size_t)(l * 2 + j) * 64 * KiB), scr, kb, nb, c.lane, n < 64 ? n : -1); }
    }
    for (int it = c.gw; it < 2 * 2048; it += c.ngw) { const int l = it >> 11, row = it & 2047;
        f32x4 v[4]; row_load(c.in[1] + (size_t)row * DM, c.lane, v);
        const float rs = rsq(row_ss(v) * (1.f / DM) + EPS);
        row_norm_store(v, rs, c.in[20] + (size_t)l * DM, c.wsb(WS_MEMN + (size_t)l * 4 * MiB) + (size_t)row * DM, c.lane); }
    const int gt = c.blk * NTHREADS + c.tid, ngt = c.G * NTHREADS;
    for (int i = gt; i < 4 * 256; i += ngt) { const int lj = i >> 8, n = i & 255; float s = 0.f;
        if (n < 128) { const float* pe = c.in[6] + (size_t)lj * 2048; const float* w1 = c.in[7] + (size_t)lj * 2048 * 128 + n;
            for (int k = 0; k < 2048; ++k) s += pe[k] * w1[(size_t)k * 128]; }
        c.wsf(WS_CB1)[i] = s; }
    float* cosA = c.wsf(WS_ROPE); float* sinA = cosA + 4096 * 32; float* cosD = sinA + 4096 * 32; float* sinD = cosD + 4096 * 16;
    for (int i = gt; i < 4096 * 48; i += ngt) {
        const bool isA = i < 4096 * 32; const int j = isA ? i : i - 4096 * 32; const int pos = isA ? (j >> 5) : (j >> 4), fi = isA ? (j & 31) : (j & 15); const int dim = isA ? 64 : 32;
        const float invf = (float)exp2(-((double)(2 * fi) / (double)dim) * 13.287712379549449);
        const float ang = (float)pos * invf; const double rev = (double)ang * 0.15915494309189535; const float fr = (float)(rev - floor(rev));
        const float cs = __builtin_amdgcn_cosf(fr), sn = __builtin_amdgcn_sinf(fr);
        if (isA) { cosA[j] = cs; sinA[j] = sn; } else { cosD[j] = cs; sinD[j] = sn; } }
    for (int i = gt; i < 2 * 64 * 1024; i += ngt) { const int l = i >> 16, r = i & 65535, e = r >> 10, k = r & 1023;
        float v = 0.f; if (e < 4) v = c.in[26][(size_t)l * DM * 4 + k * 4 + e]; else if (e < 36) v = c.in[28][(size_t)l * DM * 32 + k * 32 + (e - 4)];
        v *= c.in[25][(size_t)l * DM + k]; const bf16 hi = f2bf(v); const bf16 lo = f2bf(v - bf2f(hi));
        c.wsb(WS_WRT)[(size_t)(l * 2) * 65536 + r] = hi; c.wsb(WS_WRT)[(size_t)(l * 2 + 1) * 65536 + r] = lo; }
}

DI void convert_moe_weights(const Ctx& c, int gw0, int ngw0) {
    LAS float* scr = (LAS float*)(c.lds + c.wave * 16384);
    constexpr int I13 = 16 * 16, I2 = 4 * 32;
    const int l = c.l;
    for (int it = gw0; it < 32 * (I13 + I2); it += ngw0) {
        const int e = it / (I13 + I2); int r = it % (I13 + I2); const int ln = c.lane & 31;
        if (r < I13) { const int kb = r / 16, nb = r % 16; const int n0 = 32 * nb; const int pn = n0 >> 8, bj = (n0 >> 7) & 1, f = pn * 128 + (n0 & 127) + ln;
            const float* src = (bj ? c.in[31] : c.in[30]) + (size_t)(l * 32 + e) * DM * 256;
            transpose_item(src, DM, 256, c.wsb(WS_MW13 + (size_t)e * MiB), scr, kb, nb, c.lane, f, c.in[25] + (size_t)l * DM); }
        else { r -= I13; const int kb = r / 32, nb = r % 32;
            transpose_item(c.in[32] + (size_t)(l * 32 + e) * 256 * DM, 256, DM, c.wsb(WS_MW2 + (size_t)e * 512 * KiB), scr, kb, nb, c.lane, 32 * nb + ln); }
    }
}

DI void moe_combine_row(const Ctx& c, int row, f32x4 (&v)[4]) {
    const int* ts = c.wsi(WS_TOKS) + 2 * row; const float* tw = c.wsf(WS_TOKW) + 2 * row;
    const int sa = ts[0], sb = ts[1]; const float wa = tw[0], wb = tw[1];
    const bf16* ya = c.wsb(WS_YMOE) + (size_t)sa * DM; const bf16* yb = c.wsb(WS_YMOE) + (size_t)sb * DM;
#pragma unroll
    for (int j = 0; j < 4; ++j) { const u32x2 a = *(const u32x2*)(ya + 4 * c.lane + 256 * j), b = *(const u32x2*)(yb + 4 * c.lane + 256 * j);
        v[j][0] += wa * bflo(a.x) + wb * bflo(b.x); v[j][1] += wa * bfhi(a.x) + wb * bfhi(b.x);
        v[j][2] += wa * bflo(a.y) + wb * bflo(b.y); v[j][3] += wa * bfhi(a.y) + wb * bfhi(b.y); }
}
DI void moe_combine_vals(const Ctx& c, int sa, int sb, float wa, float wb, f32x4 (&v)[4]) {
    const bf16* ya = c.wsb(WS_YMOE) + (size_t)sa * DM; const bf16* yb = c.wsb(WS_YMOE) + (size_t)sb * DM;
#pragma unroll
    for (int j = 0; j < 4; ++j) { const u32x2 a = *(const u32x2*)(ya + 4 * c.lane + 256 * j), b = *(const u32x2*)(yb + 4 * c.lane + 256 * j);
        v[j][0] += wa * bflo(a.x) + wb * bflo(b.x); v[j][1] += wa * bfhi(a.x) + wb * bfhi(b.x);
        v[j][2] += wa * bflo(a.y) + wb * bflo(b.y); v[j][3] += wa * bfhi(a.y) + wb * bfhi(b.y); }
}
DI void phase_norm_mix(const Ctx& c, bool dry) {
    const float* g = c.in[2] + (size_t)c.l * DM; bf16* hn = c.wsb(WS_HN);
    if (c.l == 0) {
#pragma unroll 2
        for (int row = c.gw; row < T; row += c.ngw) { f32x4 v[4]; row_load(c.in[0] + (size_t)row * DM, c.lane, v);
            const float rs = rsq(row_ss(v) * (1.f / DM) + EPS); row_norm_store(v, rs, g, hn + (size_t)row * DM, c.lane); }
        return; }
    for (int base = c.gw; base < T; base += 64 * c.ngw) {
        const int myrow = base + c.lane * c.ngw; int sa_ = 0, sb_ = 0; float wa_ = 0.f, wb_ = 0.f;
        if (myrow < T) { const int* ts = c.wsi(WS_TOKS) + 2 * myrow; const float* tw = c.wsf(WS_TOKW) + 2 * myrow; sa_ = ts[0]; sb_ = ts[1]; wa_ = tw[0]; wb_ = tw[1]; }
#pragma unroll 2
        for (int k = 0; k < 64; ++k) { const int row = base + k * c.ngw; if (row >= T) break;
            const int sa = __builtin_amdgcn_readlane(sa_, k), sb = __builtin_amdgcn_readlane(sb_, k);
            const float wa = __builtin_bit_cast(float, __builtin_amdgcn_readlane(__builtin_bit_cast(int, wa_), k)), wb = __builtin_bit_cast(float, __builtin_amdgcn_readlane(__builtin_bit_cast(int, wb_), k));
            f32x4 v[4]; bf16* rp = c.wsb(WS_RES) + (size_t)row * DM; row_load_bf(rp, c.lane, v);
            moe_combine_vals(c, sa, sb, wa, wb, v);
            if (!dry) row_store_bf(rp, c.lane, v);
            const float rs = rsq(row_ss(v) * (1.f / DM) + EPS);
            row_norm_store(v, rs, g, hn + (size_t)row * DM, c.lane); }
    }
}
DI void phase_final(const Ctx& c) {
    for (int base = c.gw; base < T; base += 64 * c.ngw) {
        const int myrow = base + c.lane * c.ngw; int sa_ = 0, sb_ = 0; float wa_ = 0.f, wb_ = 0.f;
        if (myrow < T) { const int* ts = c.wsi(WS_TOKS) + 2 * myrow; const float* tw = c.wsf(WS_TOKW) + 2 * myrow; sa_ = ts[0]; sb_ = ts[1]; wa_ = tw[0]; wb_ = tw[1]; }
#pragma unroll 2
        for (int k = 0; k < 64; ++k) { const int row = base + k * c.ngw; if (row >= T) break;
            const int sa = __builtin_amdgcn_readlane(sa_, k), sb = __builtin_amdgcn_readlane(sb_, k);
            const float wa = __builtin_bit_cast(float, __builtin_amdgcn_readlane(__builtin_bit_cast(int, wa_), k)), wb = __builtin_bit_cast(float, __builtin_amdgcn_readlane(__builtin_bit_cast(int, wb_), k));
            f32x4 v[4]; row_load_bf(c.wsb(WS_RES) + (size_t)row * DM, c.lane, v); moe_combine_vals(c, sa, sb, wa, wb, v);
#pragma unroll
            for (int j = 0; j < 4; ++j) *(f32x4*)(c.out + (size_t)row * DM + 4 * c.lane + 256 * j) = v[j]; }
    }
}
DI void phase_prep(const Ctx& c, bool dry) {
    const float* cosA = c.wsf(WS_ROPE); const float* sinA = cosA + 4096 * 32; const float* cosD = sinA + 4096 * 32; const float* sinD = cosD + 4096 * 16;
    const float* ng = c.in[5] + (size_t)c.l * 256;
    const float* dg = c.in[16] + (size_t)c.l * 64;
    bf16* kcr = c.wsb(WS_KCR); bf16* vcr = c.wsb(WS_VCR);
    const int L = c.lane;
    const int hdA = L >> 3, chA = L & 7; const int colA = (hdA < 4 ? A_Q + 64 * hdA : (hdA == 4 ? A_KS : (hdA == 5 ? A_KW : (hdA == 6 ? A_KC : A_VC)))) + 8 * chA;
    const float* gA = ng + (hdA < 4 ? 0 : (hdA == 4 ? 128 : 192)) + 8 * chA; const int ddA = (chA & 3) * 8;
    const int idB = L >> 2, chB = L & 3; const bool isq = idB < 8; const int colB = (isq ? D_Q : D_K) + 32 * (idB & 7) + 8 * chB;
    const float* gB = dg + (isq ? 0 : 32) + 8 * chB; const int ddB = (chB & 1) * 8;
    float gav[8], gbv[8];
#pragma unroll
    for (int i = 0; i < 8; ++i) { gav[i] = (hdA < 6) ? gA[i] : 0.f; gbv[i] = gB[i]; }
#pragma unroll 2
    for (int row = c.gw; row < T; row += c.ngw) {
        const int pos = row & (SEQ - 1); bf16* pr = c.wsb(WS_PROJ) + (size_t)row * PC;
        const u32x4 va = *(const u32x4*)(pr + colA), vb = *(const u32x4*)(pr + colB);
        const f32x4 ca0 = *(const f32x4*)(cosA + pos * 32 + ddA), ca1 = *(const f32x4*)(cosA + pos * 32 + ddA + 4), sa0 = *(const f32x4*)(sinA + pos * 32 + ddA), sa1 = *(const f32x4*)(sinA + pos * 32 + ddA + 4);
        const f32x4 cb0 = *(const f32x4*)(cosD + pos * 16 + ddB), cb1 = *(const f32x4*)(cosD + pos * 16 + ddB + 4), sb0 = *(const f32x4*)(sinD + pos * 16 + ddB), sb1 = *(const f32x4*)(sinD + pos * 16 + ddB + 4);
        { float x[8] = {bflo(va.x), bfhi(va.x), bflo(va.y), bfhi(va.y), bflo(va.z), bfhi(va.z), bflo(va.w), bfhi(va.w)}; float ss = 0.f;
#pragma unroll
            for (int i = 0; i < 8; ++i) ss += x[i] * x[i];
            ss += shx(ss, 1); ss += shx(ss, 2); ss += shx(ss, 4);
            const float rs = rsq(ss * (1.f / 64) + EPS); const float cs[8] = {ca0[0], ca0[1], ca0[2], ca0[3], ca1[0], ca1[1], ca1[2], ca1[3]}; const float sn[8] = {sa0[0], sa0[1], sa0[2], sa0[3], sa1[0], sa1[1], sa1[2], sa1[3]};
            float o[8];
#pragma unroll
            for (int i = 0; i < 8; ++i) { const float y = x[i] * rs * gav[i]; const float p = shx(y, 4); float v = (chA < 4) ? y * cs[i] - p * sn[i] : y * cs[i] + p * sn[i]; if (hdA < 4) v *= QSCALE; o[i] = dry ? x[i] : v; }
            if (hdA < 6) *(u32x4*)(pr + colA) = f8_to_bf(o);
            else *(u32x4*)((hdA == 6 ? kcr : vcr) + (size_t)row * 64 + 8 * chA) = va; }
        { float x[8] = {bflo(vb.x), bfhi(vb.x), bflo(vb.y), bfhi(vb.y), bflo(vb.z), bfhi(vb.z), bflo(vb.w), bfhi(vb.w)}; float ss = 0.f;
#pragma unroll
            for (int i = 0; i < 8; ++i) ss += x[i] * x[i];
            ss += shx(ss, 1); ss += shx(ss, 2);
            const float rs = rsq(ss * (1.f / 32) + EPS); const float cs[8] = {cb0[0], cb0[1], cb0[2], cb0[3], cb1[0], cb1[1], cb1[2], cb1[3]}; const float sn[8] = {sb0[0], sb0[1], sb0[2], sb0[3], sb1[0], sb1[1], sb1[2], sb1[3]};
            float o[8];
#pragma unroll
            for (int i = 0; i < 8; ++i) { const float y = x[i] * rs * gbv[i]; const float p = shx(y, 2); float v = (chB < 2) ? y * cs[i] - p * sn[i] : y * cs[i] + p * sn[i]; if (isq) v *= DSCALE; o[i] = dry ? x[i] : v; }
            *(u32x4*)(pr + colB) = f8_to_bf(o); }
    }
}

DI void cmp_finish_rows(const Ctx& c, int kind, int row0) {
    const float* cosA = c.wsf(WS_ROPE); const float* sinA = cosA + 4096 * 32;
    const float* g = c.in[5] + (size_t)c.l * 256 + 64;
    for (int row = row0 + c.wave; row < row0 + 256; row += NWAVES) {
        if (kind) { c.wsb(WS_VCN)[(size_t)row * 64 + c.lane] = f2bf(c.wsf(WS_VCL)[(size_t)row * 64 + c.lane]); continue; }
        const int kg = row & 255; int ps = 16 * kg + 31; ps = ps > 4095 ? 4095 : ps;
        const int d = c.lane & 31, hh = c.lane >> 5;
        const float x = c.wsf(WS_KCL)[(size_t)row * 64 + c.lane];
        float ss = wsum(x * x);
        const float y = x * rsq(ss * (1.f / 64) + EPS) * g[c.lane];
        const float pr = shx(y, 32);
        const float cs = cosA[ps * 32 + d], sn = sinA[ps * 32 + d];
        const float o = hh ? y * cs + pr * sn : y * cs - pr * sn;
        c.wsb(WS_KCN)[(size_t)row * 64 + c.lane] = f2bf(o);
    }
}

DI void phase_cmp_stage2(const Ctx& c, int it0, int it1, int gw0, int ngw0) {
    const float* cosA = c.wsf(WS_ROPE); const float* sinA = cosA + 4096 * 32;
    const float* g = c.in[5] + (size_t)c.l * 256 + 64; const int d = c.lane & 31, hh = c.lane >> 5; const float gl = g[c.lane];
    for (int it = it0 + gw0; it < it1; it += ngw0) { const int kind = it >> 11, row = it & 2047; const int kg = row & 255;
        const float* w2 = c.in[8] + (size_t)(c.l * 2 + kind) * 128 * 64 + c.lane;
        const unsigned hraw = *(const unsigned*)(c.wsb(WS_HID) + (size_t)kind * 2048 * 256 + (size_t)row * 256 + 2 * c.lane);
        const float* b1 = c.wsf(WS_CB1) + c.l * 512 + kind * 256 + 2 * c.lane;
        const unsigned hv = pk2(gelu_tanh(bflo(hraw) + b1[0]), gelu_tanh(bfhi(hraw) + b1[1]));
        float a0 = 0.f, a1 = 0.f;
#pragma unroll
        for (int k2 = 0; k2 < 64; ++k2) { const unsigned hk = (unsigned)__builtin_amdgcn_readlane((int)hv, k2); a0 += bflo(hk) * w2[(2 * k2) * 64]; a1 += bfhi(hk) * w2[(2 * k2 + 1) * 64]; }
        float x = (kg == 255) ? 0.f : a0 + a1;
        if (kind) { c.wsb(WS_VCN)[(size_t)row * 64 + c.lane] = f2bf(x); continue; }
        int ps = 16 * kg + 31; ps = ps > 4095 ? 4095 : ps;
        const float ss = wsum(x * x); const float y = x * rsq(ss * (1.f / 64) + EPS) * gl; const float pr = shx(y, 32);
        const float cs = cosA[ps * 32 + d], sn = sinA[ps * 32 + d];
        c.wsb(WS_KCN)[(size_t)row * 64 + c.lane] = f2bf(hh ? y * cs + pr * sn : y * cs - pr * sn);
    }
}

constexpr int KP = 72, VP = 68;
constexpr int KT_BYTES = 64 * KP * 2, VT_BYTES = 64 * VP * 2;

DI bf16x8 pack8(const f32x16& s, int st) {
    u32x4 p; p.x = pk2(s[8 * st + 0], s[8 * st + 1]); p.y = pk2(s[8 * st + 2], s[8 * st + 3]); p.z = pk2(s[8 * st + 4], s[8 * st + 5]); p.w = pk2(s[8 * st + 6], s[8 * st + 7]);
    return __builtin_bit_cast(bf16x8, p);
}
DI bf16x8 vfrag(const LAS bf16* p) {
    const u32x2 lo = *(const LAS u32x2*)p, hi = *(const LAS u32x2*)(p + 8);
    u32x4 r; r.x = lo.x; r.y = lo.y; r.z = hi.x; r.w = hi.y; return __builtin_bit_cast(bf16x8, r);
}
template <int NKS>
DI void qk_tile(f32x16& s0, f32x16& s1, const LAS bf16* Kt, int koff, const bf16x8* qf, int r32, int hi) {
#pragma unroll
    for (int i = 0; i < 16; ++i) { s0[i] = 0.f; s1[i] = 0.f; }
#pragma unroll
    for (int s = 0; s < NKS; ++s) {
        const bf16x8 a0 = *(const LAS bf16x8*)(Kt + r32 * KP + koff + 16 * s + 8 * hi);
        const bf16x8 a1 = *(const LAS bf16x8*)(Kt + (32 + r32) * KP + koff + 16 * s + 8 * hi);
        s0 = MFMA32(a0, qf[s], s0); s1 = MFMA32(a1, qf[s], s1);
    }
    __builtin_amdgcn_sched_barrier(0);
}
DI void pv_tile(f32x16& o0, f32x16& o1, const bf16x8 p00, const bf16x8 p01, const bf16x8 p10, const bf16x8 p11, const LAS bf16* Vt, int r32, int hi) {
    const LAS bf16* v0 = Vt + r32 * VP + 4 * hi; const LAS bf16* v1 = Vt + (32 + r32) * VP + 4 * hi;
    __builtin_amdgcn_sched_barrier(0);
    o0 = MFMA32(vfrag(v0), p00, o0); o0 = MFMA32(vfrag(v0 + 16), p01, o0); o0 = MFMA32(vfrag(v0 + 32), p10, o0); o0 = MFMA32(vfrag(v0 + 48), p11, o0);
    __builtin_amdgcn_sched_barrier(0);
    o1 = MFMA32(vfrag(v1), p00, o1); o1 = MFMA32(vfrag(v1 + 16), p01, o1); o1 = MFMA32(vfrag(v1 + 32), p10, o1); o1 = MFMA32(vfrag(v1 + 48), p11, o1);
    __builtin_amdgcn_sched_barrier(0);
}
typedef short v4i16_t __attribute__((ext_vector_type(4)));
DI bf16x8 vfrag_tr(const LAS bf16* p) {
    const s16x4 lo = __builtin_bit_cast(s16x4, __builtin_amdgcn_ds_read_tr16_b64_v4i16((LAS v4i16_t*)p));
    const s16x4 hi = __builtin_bit_cast(s16x4, __builtin_amdgcn_ds_read_tr16_b64_v4i16((LAS v4i16_t*)(p + 8 * KP)));
    return __builtin_shufflevector(lo, hi, 0, 1, 2, 3, 4, 5, 6, 7);
}
DI void pv_tile_tr(f32x16& o0, f32x16& o1, const bf16x8 p00, const bf16x8 p01, const bf16x8 p10, const bf16x8 p11, const LAS bf16* Vr, int lane) {
    const int i16 = lane & 15; const LAS bf16* b0 = Vr + (4 * (lane >> 5) + (i16 >> 2)) * KP + 16 * ((lane >> 4) & 1) + 4 * (i16 & 3);
    __builtin_amdgcn_sched_barrier(0);
    o0 = MFMA32(vfrag_tr(b0), p00, o0); o0 = MFMA32(vfrag_tr(b0 + 16 * KP), p01, o0); o0 = MFMA32(vfrag_tr(b0 + 32 * KP), p10, o0); o0 = MFMA32(vfrag_tr(b0 + 48 * KP), p11, o0);
    __builtin_amdgcn_sched_barrier(0);
    o1 = MFMA32(vfrag_tr(b0 + 32), p00, o1); o1 = MFMA32(vfrag_tr(b0 + 32 + 16 * KP), p01, o1); o1 = MFMA32(vfrag_tr(b0 + 32 + 32 * KP), p10, o1); o1 = MFMA32(vfrag_tr(b0 + 32 + 48 * KP), p11, o1);
    __builtin_amdgcn_sched_barrier(0);
}
struct MaskNone { DI bool operator()(int) const { return true; } };
struct MaskLe { int lim; DI bool operator()(int cr) const { return cr <= lim; } };
struct MaskWin { int lim; DI bool operator()(int cr) const { return cr <= lim && cr > lim - 512; } };
template <class M>
DI void softmax_tile(f32x16& s0, f32x16& s1, float& m, float& l, float& alpha, const M& mk, bf16x8& p00, bf16x8& p01, bf16x8& p10, bf16x8& p11, bool lane_on = true) {
    float tm = -1e30f;
#pragma unroll
    for (int r = 0; r < 16; ++r) { tm = fmaxf(tm, mk(CR(r)) ? s0[r] : -1e30f); tm = fmaxf(tm, mk(CR(r) + 32) ? s1[r] : -1e30f); }
    tm = fmaxf(tm, shx(tm, 32));
    if (!lane_on) tm = -1e30f;
    const float mn = fmaxf(m, tm);
    alpha = ex2(m - mn);
    const float sub = lane_on ? mn : 1e30f;
    float ls = 0.f;
    __builtin_amdgcn_sched_barrier(0);
#pragma unroll
    for (int r = 0; r < 16; ++r) { const float p = mk(CR(r)) ? ex2(s0[r] - sub) : 0.f; ls += p; s0[r] = p; }
    p00 = pack8(s0, 0); p01 = pack8(s0, 1);
    __builtin_amdgcn_sched_barrier(0);
#pragma unroll
    for (int r = 0; r < 16; ++r) { const float p = mk(CR(r) + 32) ? ex2(s1[r] - sub) : 0.f; ls += p; s1[r] = p; }
    p10 = pack8(s1, 0); p11 = pack8(s1, 1);
    ls += shx(ls, 32);
    l = l * alpha + ls; m = mn;
    __builtin_amdgcn_sched_barrier(0);
}
#define RESCALE(o0_, o1_, al_) do { if (!__all((al_) == 1.f)) { _Pragma("unroll") for (int i_ = 0; i_ < 16; ++i_) { o0_[i_] *= (al_); o1_[i_] *= (al_); } } } while (0)
DI u32x4 ldk16(const bf16* src, int pitch, int tid) { return *(const u32x4*)(src + (size_t)(tid >> 3) * pitch + (tid & 7) * 8); }
DI void stk16(LAS bf16* Kt, u32x4 v, int tid) { *(LAS u32x4*)(Kt + (tid >> 3) * KP + (tid & 7) * 8) = v; }
DI u32x4 ldv16(const bf16* src, int pitch, int tid) { return *(const u32x4*)(src + (size_t)(tid & 63) * pitch + (tid >> 6) * 8); }
DI void stvt(LAS bf16* Vt, u32x4 v, int tid) {
    const int key = tid & 63, d0 = (tid >> 6) * 8; LAS bf16* p = Vt + d0 * VP + key;
    p[0] = (bf16)(v.x & 0xffffu); p[VP] = (bf16)(v.x >> 16); p[2 * VP] = (bf16)(v.y & 0xffffu); p[3 * VP] = (bf16)(v.y >> 16);
    p[4 * VP] = (bf16)(v.z & 0xffffu); p[5 * VP] = (bf16)(v.z >> 16); p[6 * VP] = (bf16)(v.w & 0xffffu); p[7 * VP] = (bf16)(v.w >> 16);
}

#define SBAR() __builtin_amdgcn_sched_barrier(0)
#define PINV(x) asm volatile("" : "+v"(x))
constexpr float ATHR = 8.f;
constexpr int RING_BYTES = 4 * KT_BYTES;
DI float pel(const f32x16& a, const f32x16& b, int i) { return i < 16 ? a[i] : b[i - 16]; }
DI float bf16r(float x) { return bflo(pk2(x, x)); }
DI float rowmax_local(const f32x16& p0, const f32x16& p1) {
    float a = fmaxf(fmaxf(p0[0], p0[1]), p1[0]), b = fmaxf(fmaxf(p0[2], p0[3]), p1[1]); a = fmaxf(fmaxf(a, p1[2]), p1[3]);
#pragma unroll
    for (int r = 4; r < 16; r += 4) { a = fmaxf(fmaxf(a, p0[r]), p0[r + 1]); b = fmaxf(fmaxf(b, p0[r + 2]), p0[r + 3]); a = fmaxf(fmaxf(a, p1[r]), p1[r + 1]); b = fmaxf(fmaxf(b, p1[r + 2]), p1[r + 3]); }
    return fmaxf(a, b);
}
DI float xhalf_max(float x) { return fmaxf(x, shx(x, 32)); }
DI float xhalf_sum(float x) { return x + shx(x, 32); }
DI float rowmax32(const f32x16& p0, const f32x16& p1) { return xhalf_max(rowmax_local(p0, p1)); }
DI unsigned cvtpk_pin(float lo, float hi) { unsigned r; asm volatile("v_cvt_pk_bf16_f32 %0, %1, %2" : "=v"(r) : "v"(lo), "v"(hi)); return r; }
DI u32x4 ldg16(const bf16* base, unsigned boff) { return *(const u32x4*)((const char*)base + boff); }
#define AS_VRD(vp, i) vf[i] = vfrag_tr((vp) + 32 * ((i) >> 2) + 16 * KP * ((i) & 3))
#define AS_KPAIR(kp, d) do { kf[2 * ((d) & 1)] = *(const LAS bf16x8*)((kp) + 16 * (d)); kf[2 * ((d) & 1) + 1] = *(const LAS bf16x8*)((kp) + 32 * KP + 16 * (d)); } while (0)
#define AS_QX(t) do { u32x4 q_; q_.x = (__builtin_bit_cast(unsigned, -mref) >> 16) | (rowoff(t) << 16); q_.y = 0u; q_.z = 0u; q_.w = 0u; qx = __builtin_bit_cast(bf16x8, q_); } while (0)
#define AS_PACK(P0, P1, i) do { pwd[2 * (i)] = cvtpk_pin(pel(P0, P1, 4 * (i)), pel(P0, P1, 4 * (i) + 1)); pwd[2 * (i) + 1] = cvtpk_pin(pel(P0, P1, 4 * (i) + 2), pel(P0, P1, 4 * (i) + 3)); } while (0)
#define AS_PW(k) __builtin_bit_cast(bf16x8, (u32x4){pwd[4 * (k)], pwd[4 * (k) + 1], pwd[4 * (k) + 2], pwd[4 * (k) + 3]})
#define AS_PHASEA(C0, C1, P0, P1, vp, kp) do { float sacc = P0[0] + P0[1]; AS_KPAIR(kp, 0); \
    _Pragma("unroll") for (int j = 0; j < NQ; ++j) { \
        const int c0 = (NQ >= 8) ? (j < 8 ? j : 8) : (j < 4 ? j : 4 + 2 * (j - 4)); \
        const int c1 = (NQ >= 8) ? (j + 1 < 8 ? j + 1 : 8) : (j + 1 < 4 ? j + 1 : 4 + 2 * (j + 1 - 4)); \
        if (j >= 2 && (j & 1) == 0 && (j >> 1) < NKS) AS_KPAIR(kp, j >> 1); \
        _Pragma("unroll") for (int i = c0; i < c1; ++i) if (i >= 4) AS_VRD(vp, i - 4); \
        SBAR(); \
        if (j == 0) C0 = MFMA32(kx, qx, zero16); else if (j == 1) C1 = MFMA32(kx, qx, zero16); \
        else if ((j & 1) == 0) C0 = MFMA32(kf[2 * (((j - 2) >> 1) & 1)], qf[(j - 2) >> 1], C0); else C1 = MFMA32(kf[2 * (((j - 2) >> 1) & 1) + 1], qf[(j - 2) >> 1], C1); \
        _Pragma("unroll") for (int i = c0; i < c1; ++i) { \
            _Pragma("unroll") for (int e = 2 + 4 * i; e < 6 + 4 * i; ++e) if (e < 32) sacc += pel(P0, P1, e); \
            AS_PACK(P0, P1, i); } \
        PINV(sacc); SBAR(); } \
    l += sacc; } while (0)
#define AS_EXP4(C0, C1, e) do { if ((e) < 16) C0[(e) & 15] = ex2(C0[(e) & 15]); else if ((e) < 32) C1[(e) & 15] = ex2(C1[(e) & 15]); } while (0)
#define AS_PHASEB(C0, C1, vp, t) do { maskfn(t, C0, C1); \
    const float rml = rowmax_local(C0, C1); const float rmo = shx(rml, 32); \
    AS_VRD(vp, 4); AS_VRD(vp, 5); SBAR(); \
    o0 = MFMA32(vf[0], AS_PW(0), o0); SBAR(); \
    o0 = MFMA32(vf[1], AS_PW(1), o0); \
    const float rm = fmaxf(rml, rmo); moved = false; SBAR(); \
    if (__any(rm > ATHR)) { const float dl = fmaxf(rm, 0.f); const float mn = bf16r(mref + dl); const float dle = mn - mref; mref = mn; fres = ex2(-dle); l *= fres; \
        _Pragma("unroll") for (int r = 0; r < 16; ++r) { C0[r] -= dle; C1[r] -= dle; } moved = true; } \
    SBAR(); \
    _Pragma("unroll") for (int g = 2; g < 8; ++g) { \
        if (g < 4) { AS_VRD(vp, 4 + g); SBAR(); } \
        if (g < 4) o0 = MFMA32(vf[g], AS_PW(g), o0); else o1 = MFMA32(vf[g], AS_PW(g - 4), o1); \
        _Pragma("unroll") for (int e = ((g - 2) * 16 + 2) / 3; e < ((g - 1) * 16 + 2) / 3; ++e) AS_EXP4(C0, C1, e); \
        PINV(C0); PINV(C1); \
        SBAR(); } \
    if (moved) { _Pragma("unroll") for (int r = 0; r < 16; ++r) { o0[r] *= fres; o1[r] *= fres; } } } while (0)
#define AS_STEP(C0, C1, P0, P1, t) do { \
    const LAS bf16* vp_ = ringe + (2 + (((t) - 1) & 1)) * SLOT + vfo; const LAS bf16* kp_ = ringe + ((t) & 1) * SLOT + kfo; \
    AS_QX(t); SBAR(); AS_PHASEA(C0, C1, P0, P1, vp_, kp_); AS_PHASEB(C0, C1, vp_, t); } while (0)
#define AS_DRAIN(P0, P1, tl) do { const LAS bf16* vp_ = ringe + (2 + ((tl) & 1)) * SLOT + vfo; \
    _Pragma("unroll") for (int i = 0; i < 8; ++i) AS_VRD(vp_, i); \
    float sacc = 0.f; _Pragma("unroll") for (int e = 0; e < 32; ++e) sacc += pel(P0, P1, e); l += sacc; \
    _Pragma("unroll") for (int i = 0; i < 8; ++i) AS_PACK(P0, P1, i); \
    _Pragma("unroll") for (int g = 0; g < 8; ++g) { if (g < 4) o0 = MFMA32(vf[g], AS_PW(g), o0); else o1 = MFMA32(vf[g], AS_PW(g - 4), o1); } \
    SBAR(); } while (0)
#define AS_STAGE(t) do { *(LAS u32x4*)(ringe + (((t) + 1) & 1) * SLOT + sto) = kreg; *(LAS u32x4*)(ringe + (2 + ((t) & 1)) * SLOT + sto) = vreg; \
    kreg = ldg16(ksrc(((t) + 2 < NT) ? (t) + 2 : NT - 1), goff); vreg = ldg16(vsrc(((t) + 1 < NT) ? (t) + 1 : NT - 1), goff); } while (0)
template <int NKS, class KS, class VS, class MF, class RO>
DI void attn_stream(f32x16& o0, f32x16& o1, float& lsum, LAS unsigned char* ring, const bf16x8* qf, const int koff, const int NT, const int NTw,
                    const KS ksrc, const VS vsrc, const MF maskfn, const RO rowoff, const int tid) {
    const int lane = tid & 63, r32 = lane & 31, hi = lane >> 5, i16 = lane & 15;
    LAS bf16* const ringe = (LAS bf16*)ring;
    constexpr int SLOT = 64 * KP, NQ = 2 * NKS + 2;
    const int kfo = r32 * KP + koff + 8 * hi;
    const int vfo = (4 * hi + (i16 >> 2)) * KP + 16 * ((lane >> 4) & 1) + 4 * (i16 & 3);
    const int sto = (tid >> 3) * KP + (tid & 7) * 8;
    const unsigned goff = (unsigned)(((tid >> 3) * PC + (tid & 7) * 8) * 2);
    bf16x8 kx; { u32x4 t_; t_.x = hi ? 0u : 0x3F803F80u; t_.y = 0u; t_.z = 0u; t_.w = 0u; kx = __builtin_bit_cast(bf16x8, t_); }
    const f32x16 zero16 = {0.f, 0.f, 0.f, 0.f, 0.f, 0.f, 0.f, 0.f, 0.f, 0.f, 0.f, 0.f, 0.f, 0.f, 0.f, 0.f};
    f32x16 pA0, pA1, pB0, pB1; bf16x8 kf[4], vf[8], qx; unsigned pwd[16];
    float l = 0.f, mref = 0.f, fres = 1.f; bool moved = false;
#pragma unroll
    for (int i = 0; i < 16; ++i) { o0[i] = 0.f; o1[i] = 0.f; }
    u32x4 kreg, vreg;
    {
        const u32x4 k0 = ldg16(ksrc(0), goff), k1 = ldg16(ksrc(NT > 1 ? 1 : 0), goff), v0 = ldg16(vsrc(0), goff);
        kreg = ldg16(ksrc(NT > 2 ? 2 : NT - 1), goff); vreg = ldg16(vsrc(NT > 1 ? 1 : 0), goff);
        *(LAS u32x4*)(ringe + sto) = k0; *(LAS u32x4*)(ringe + SLOT + sto) = k1; *(LAS u32x4*)(ringe + 2 * SLOT + sto) = v0;
    }
    __syncthreads();
    {
        AS_QX(0);
        pA0 = MFMA32(kx, qx, zero16); pA1 = MFMA32(kx, qx, zero16);
#pragma unroll
        for (int d = 0; d < NKS; ++d) { const bf16x8 a0 = *(const LAS bf16x8*)(ringe + kfo + 16 * d), a1 = *(const LAS bf16x8*)(ringe + kfo + 32 * KP + 16 * d); pA0 = MFMA32(a0, qf[d], pA0); pA1 = MFMA32(a1, qf[d], pA1); }
        maskfn(0, pA0, pA1);
        mref = bf16r(fmaxf(rowmax32(pA0, pA1), -1e4f));
#pragma unroll
        for (int r = 0; r < 16; ++r) { pA0[r] = ex2(pA0[r] - mref); pA1[r] = ex2(pA1[r] - mref); }
    }
    __syncthreads();
    int t = 1;
#pragma unroll 1
    for (; t + 1 < NTw; t += 2) {
        AS_STAGE(t); AS_STEP(pB0, pB1, pA0, pA1, t); __syncthreads();
        AS_STAGE(t + 1); AS_STEP(pA0, pA1, pB0, pB1, t + 1); __syncthreads();
    }
    if (t < NTw) { AS_STAGE(t); AS_STEP(pB0, pB1, pA0, pA1, t); __syncthreads(); AS_DRAIN(pB0, pB1, t); ++t; }
    else AS_DRAIN(pA0, pA1, t - 1);
#pragma unroll 1
    for (; t < NT; ++t) { AS_STAGE(t); __syncthreads(); }
    lsum = xhalf_sum(l);
    __syncthreads();
}

DI void nsa_item(const Ctx& c, int b, int tb) {
    LAS bf16* Kt0 = (LAS bf16*)(c.lds); LAS bf16* Kt1 = (LAS bf16*)(c.lds + KT_BYTES);
    LAS bf16* Vt0 = (LAS bf16*)(c.lds + 2 * KT_BYTES); LAS bf16* Vt1 = (LAS bf16*)(c.lds + 3 * KT_BYTES);
    LAS float* impA = (LAS float*)(c.lds + RING_BYTES); LAS float* impB = impA + 64 * 65;
    LAS float* accL = (LAS float*)(c.lds + RING_BYTES);
    LAS unsigned* selm = (LAS unsigned*)(c.lds + RING_BYTES + 8 * 32 * 64 * 4);
    int tid = c.tid; asm volatile("" : "+v"(tid)); const int lane = tid & 63, w = __builtin_amdgcn_readfirstlane(tid >> 6), r32 = lane & 31, hi = lane >> 5;
    const int tokl = 8 * w + (r32 >> 2), head = r32 & 3;
    const int row = b * SEQ + 64 * tb + tokl, pos = 64 * tb + tokl;
    const bf16* proj = c.wsb(WS_PROJ); const bf16* prow = proj + (size_t)row * PC;
    const bf16* pb = proj + (size_t)b * SEQ * PC;
    bf16x8 qf[4];
#pragma unroll
    for (int s = 0; s < 4; ++s) qf[s] = *(const bf16x8*)(prow + A_Q + head * 64 + 16 * s + 8 * hi);
    const float g_c = sigm(bf2f(prow[SMC + head * 3 + 0])), g_s = sigm(bf2f(prow[SMC + head * 3 + 1])), g_w = sigm(bf2f(prow[SMC + head * 3 + 2]));
    f32x16 acc0, acc1;
#pragma unroll
    for (int i = 0; i < 16; ++i) { acc0[i] = 0.f; acc1[i] = 0.f; }
    __syncthreads();
    for (int i = tid; i < 2 * 64 * 65; i += NTHREADS) impA[i] = 0.f;
    __syncthreads();
    const int ncmp = 4 * tb + 3; const int ntc = (ncmp + 63) >> 6;
    const bf16* kcn = c.wsb(WS_KCN) + (size_t)b * 256 * 64; const bf16* vcn = c.wsb(WS_VCN) + (size_t)b * 256 * 64;
    float mC = -1e30f, lC = 0.f;
    const int klim = (pos - 31) >> 4;
#pragma unroll 1
    for (int it = 0; it < ntc; ++it) {
        __syncthreads();
        stk16(Kt0, ldk16(kcn + (size_t)(64 * it) * 64, 64, tid), tid);
        __syncthreads();
        f32x16 s0, s1; qk_tile<4>(s0, s1, Kt0, 0, qf, r32, hi);
        const MaskLe mk{klim - (64 * it + 4 * hi)};
        float al; bf16x8 q0, q1, q2, q3; softmax_tile(s0, s1, mC, lC, al, mk, q0, q1, q2, q3);
    }
    {
        f32x16 o0, o1;
#pragma unroll
        for (int i = 0; i < 16; ++i) { o0[i] = 0.f; o1[i] = 0.f; }
        const float inv = lC > 0.f ? 1.f / lC : 0.f;
#pragma unroll 1
        for (int it = 0; it < ntc; ++it) {
            __syncthreads();
            stk16(Kt0, ldk16(kcn + (size_t)(64 * it) * 64, 64, tid), tid); stk16(Vt0, ldk16(vcn + (size_t)(64 * it) * 64, 64, tid), tid);
            __syncthreads();
            f32x16 s0, s1; qk_tile<4>(s0, s1, Kt0, 0, qf, r32, hi);
            const MaskLe mk{klim - (64 * it + 4 * hi)};
#pragma unroll
            for (int r = 0; r < 16; ++r) { s0[r] = mk(CR(r)) ? ex2(s0[r] - mC) * inv : 0.f; s1[r] = mk(CR(r) + 32) ? ex2(s1[r] - mC) * inv : 0.f; }
            pv_tile_tr(o0, o1, pack8(s0, 0), pack8(s0, 1), pack8(s1, 0), pack8(s1, 1), Vt0, lane);
#pragma unroll
            for (int kb = 0; kb < 2; ++kb)
#pragma unroll
                for (int q4 = 0; q4 < 4; ++q4) { float pq[4];
#pragma unroll
                    for (int i = 0; i < 4; ++i) { float v = kb ? s1[4 * q4 + i] : s0[4 * q4 + i]; v += shx(v, 1); v += shx(v, 2); pq[i] = v; }
                    const int j = 16 * it + 8 * kb + 2 * q4 + hi;
                    if (head == 0) { impA[tokl * 65 + j] = 2.f * (pq[0] + pq[1] + pq[2]) + pq[3]; if (j + 1 < 64) impB[tokl * 65 + j + 1] = pq[3]; } }
        }
#pragma unroll
        for (int i = 0; i < 16; ++i) { acc0[i] = g_c * o0[i]; acc1[i] = g_c * o1[i]; }
    }
    __syncthreads();
    for (int tk = 0; tk < 8; ++tk) {
        const int tl = 8 * w + tk; const int j = lane; const bool valid = j <= tb;
        unsigned long long msk;
        if (tb < 16) msk = __ballot(valid);
        else {
            const float imp = impA[tl * 65 + j] + impB[tl * 65 + j];
            const bool forced = (j == 0) || (j == tb) || (j == tb - 1);
            const float sc = valid ? imp + (forced ? 1000.f : 0.f) : -1e30f;
            int rank = 0;
            for (int i = 0; i <= tb; ++i) { const float o = __builtin_bit_cast(float, __builtin_amdgcn_readlane(__builtin_bit_cast(int, sc), i)); rank += (o > sc || (o == sc && i < j)) ? 1 : 0; }
            msk = __ballot(valid && rank < 16);
        }
        if (lane == 0) { selm[2 * tl] = (unsigned)msk; selm[2 * tl + 1] = (unsigned)(msk >> 32); }
    }
    __syncthreads();
    const unsigned long long mymask = (unsigned long long)selm[2 * tokl] | ((unsigned long long)selm[2 * tokl + 1] << 32);
    LAS float* accl = accL + (w * 32) * 64 + lane;
#pragma unroll
    for (int i = 0; i < 16; ++i) { accl[i * 64] = acc0[i]; accl[(16 + i) * 64] = acc1[i]; }
    {
        f32x16 o0, o1; float l;
        const bf16* kb = pb + A_KS; const bf16* vb = pb + A_VS;
        attn_stream<4>(o0, o1, l, c.lds, qf, 0, tb + 1, tb + 1,
            [&](int t) { return kb + (size_t)(64 * t) * PC; }, [&](int t) { return vb + (size_t)(64 * t) * PC; },
            [&](int t, f32x16& C0, f32x16& C1) { if (t == tb) { const int lim = pos - (64 * t + 4 * hi);
#pragma unroll
                for (int r = 0; r < 16; ++r) { if (CR(r) > lim) C0[r] = -__builtin_inff(); if (CR(r) + 32 > lim) C1[r] = -__builtin_inff(); } } },
            [&](int t) { return ((mymask >> t) & 1ull) ? 0u : 0xFF7Fu; }, tid);
        const float sc = l > 0.f ? g_s / l : 0.f;
#pragma unroll
        for (int i = 0; i < 16; ++i) { accl[i * 64] += sc * o0[i]; accl[(16 + i) * 64] += sc * o1[i]; }
    }
    {
        f32x16 o0, o1; float l;
        const int j0 = tb >= 8 ? tb - 8 : 0; const int wminpos = 64 * tb + 8 * w;
        const bf16* kb = pb + (size_t)(64 * j0) * PC + A_KW; const bf16* vb = pb + (size_t)(64 * j0) * PC + A_VW;
        attn_stream<4>(o0, o1, l, c.lds, qf, 0, tb - j0 + 1, tb - j0 + 1,
            [&](int t) { return kb + (size_t)(64 * t) * PC; }, [&](int t) { return vb + (size_t)(64 * t) * PC; },
            [&](int t, f32x16& C0, f32x16& C1) { const int kt0 = 64 * (j0 + t);
                if (!(kt0 + 63 <= wminpos && kt0 >= wminpos + 7 - 511)) { const int lim = pos - (kt0 + 4 * hi);
#pragma unroll
                    for (int r = 0; r < 16; ++r) { if (!(CR(r) <= lim && CR(r) > lim - 512)) C0[r] = -__builtin_inff(); if (!(CR(r) + 32 <= lim && CR(r) + 32 > lim - 512)) C1[r] = -__builtin_inff(); } } },
            [&](int) { return 0u; }, tid);
        const float sc = l > 0.f ? g_w / l : 0.f;
#pragma unroll
        for (int i = 0; i < 16; ++i) { acc0[i] = accl[i * 64] + sc * o0[i]; acc1[i] = accl[(16 + i) * 64] + sc * o1[i]; }
    }
    bf16* y = c.wsb(WS_HN) + (size_t)row * DM + head * 64;
#pragma unroll
    for (int q = 0; q < 4; ++q) { const int d = 8 * q + 4 * hi;
        u32x2 w0; w0.x = pk2(acc0[4 * q], acc0[4 * q + 1]); w0.y = pk2(acc0[4 * q + 2], acc0[4 * q + 3]); *(u32x2*)(y + d) = w0;
        u32x2 w1; w1.x = pk2(acc1[4 * q], acc1[4 * q + 1]); w1.y = pk2(acc1[4 * q + 2], acc1[4 * q + 3]); *(u32x2*)(y + 32 + d) = w1; }
}

DI void diff_item(const Ctx& c, int b, int h, int qt, float lam_full, float lam_init) {
    int tid = c.tid; asm volatile("" : "+v"(tid)); const int lane = tid & 63, w = __builtin_amdgcn_readfirstlane(tid >> 6), r32 = lane & 31, hi = lane >> 5;
    const int st = w >> 2, w4 = w & 3;
    const int pos = 128 * qt + 32 * w4 + r32, row = b * SEQ + pos;
    const bf16* proj = c.wsb(WS_PROJ); const bf16* prow = proj + (size_t)row * PC; const bf16* pb = proj + (size_t)b * SEQ * PC;
    bf16x8 qf[2];
#pragma unroll
    for (int s = 0; s < 2; ++s) qf[s] = *(const bf16x8*)(prow + D_Q + h * 64 + 32 * st + 16 * s + 8 * hi);
    const int NT = 2 * qt + 2, NTw = 2 * qt + (w4 >> 1) + 1;
    f32x16 o0, o1; float l;
    const bf16* kb = pb + D_K + h * 64; const bf16* vb = pb + D_V + h * 64;
    attn_stream<2>(o0, o1, l, c.lds, qf, 32 * st, NT, NTw,
        [&](int t) { return kb + (size_t)(64 * t) * PC; }, [&](int t) { return vb + (size_t)(64 * t) * PC; },
        [&](int t, f32x16& C0, f32x16& C1) { if (t == NTw - 1) { const int lim = pos - (64 * t + 4 * hi);
#pragma unroll
            for (int r = 0; r < 16; ++r) { if (CR(r) > lim) C0[r] = -__builtin_inff(); if (CR(r) + 32 > lim) C1[r] = -__builtin_inff(); } } },
        [&](int) { return 0u; }, tid);
    LAS float* X = (LAS float*)c.lds + (w4 * 32) * 64 + lane;
    if (st == 1) { const float ib = lam_full / l;
#pragma unroll
        for (int i = 0; i < 16; ++i) { X[i * 64] = o0[i] * ib; X[(16 + i) * 64] = o1[i] * ib; } }
    __syncthreads();
    if (st == 0) {
        const float ia = 1.f / l; float ss = 0.f;
#pragma unroll
        for (int i = 0; i < 16; ++i) { o0[i] = o0[i] * ia - X[i * 64]; o1[i] = o1[i] * ia - X[(16 + i) * 64]; ss += o0[i] * o0[i] + o1[i] * o1[i]; }
        ss += shx(ss, 32);
        const float rs = rsq(ss * (1.f / 64) + EPS) * (1.f - lam_init);
        const float* ng = c.in[18] + (size_t)c.l * 64;
        bf16* y = c.wsb(WS_HN) + (size_t)row * DM + 768 + h * 64;
#pragma unroll
        for (int q = 0; q < 4; ++q) { const int d = 8 * q + 4 * hi; const f32x4 g0 = *(const f32x4*)(ng + d), g1 = *(const f32x4*)(ng + 32 + d);
            u32x2 w0; w0.x = pk2(o0[4 * q] * rs * g0[0], o0[4 * q + 1] * rs * g0[1]); w0.y = pk2(o0[4 * q + 2] * rs * g0[2], o0[4 * q + 3] * rs * g0[3]); *(u32x2*)(y + d) = w0;
            u32x2 w1; w1.x = pk2(o1[4 * q] * rs * g1[0], o1[4 * q + 1] * rs * g1[1]); w1.y = pk2(o1[4 * q + 2] * rs * g1[2], o1[4 * q + 3] * rs * g1[3]); *(u32x2*)(y + 32 + d) = w1; }
    }
    __syncthreads();
}

DI void xattn_item(const Ctx& c, int b, int h, int qt) {
    LAS bf16* Kt0 = (LAS bf16*)(c.lds); LAS bf16* Kt1 = (LAS bf16*)(c.lds + KT_BYTES);
    LAS bf16* Vt0 = (LAS bf16*)(c.lds + 2 * KT_BYTES); LAS bf16* Vt1 = (LAS bf16*)(c.lds + 3 * KT_BYTES);
    int tid = c.tid; asm volatile("" : "+v"(tid)); const int lane = tid & 63, w = __builtin_amdgcn_readfirstlane(tid >> 6), r32 = lane & 31, hi = lane >> 5;
    const int row = b * SEQ + 256 * qt + 32 * w + r32;
    const float* gq = c.in[23] + (size_t)c.l * 128; const float* gk = gq + 64;
    const bf16* xq = c.wsb(WS_XQ) + (size_t)row * 256 + h * 64; const bf16* xkv = c.wsb(WS_XKV) + (size_t)b * 256 * 512;
    bf16x8 qf[4];
    { float x[4][8]; float ss = 0.f;
#pragma unroll
        for (int s = 0; s < 4; ++s) { const u32x4 v = *(const u32x4*)(xq + 16 * s + 8 * hi);
            x[s][0] = bflo(v.x); x[s][1] = bfhi(v.x); x[s][2] = bflo(v.y); x[s][3] = bfhi(v.y); x[s][4] = bflo(v.z); x[s][5] = bfhi(v.z); x[s][6] = bflo(v.w); x[s][7] = bfhi(v.w);
#pragma unroll
            for (int i = 0; i < 8; ++i) ss += x[s][i] * x[s][i]; }
        ss += shx(ss, 32);
        const float rs = rsq(ss * (1.f / 64) + EPS) * QSCALE;
#pragma unroll
        for (int s = 0; s < 4; ++s) { float y[8];
#pragma unroll
            for (int i = 0; i < 8; ++i) y[i] = x[s][i] * rs * gq[16 * s + 8 * hi + i];
            qf[s] = __builtin_bit_cast(bf16x8, f8_to_bf(y)); } }
    f32x16 o0, o1;
#pragma unroll
    for (int i = 0; i < 16; ++i) { o0[i] = 0.f; o1[i] = 0.f; }
    float m = -1e30f, l = 0.f;
    u32x4 kr[4], vr[4];
#pragma unroll
    for (int it = 0; it < 4; ++it) { kr[it] = ldk16(xkv + (size_t)(64 * it) * 512 + h * 64, 512, tid); vr[it] = ldk16(xkv + (size_t)(64 * it) * 512 + 256 + h * 64, 512, tid); }
#pragma unroll
    for (int it = 0; it < 4; ++it) {
        LAS bf16* Kt = (it & 1) ? Kt1 : Kt0; LAS bf16* Vt = (it & 1) ? Vt1 : Vt0;
        {
            const u32x4 kreg = kr[it];
            float x[8] = {bflo(kreg.x), bfhi(kreg.x), bflo(kreg.y), bfhi(kreg.y), bflo(kreg.z), bfhi(kreg.z), bflo(kreg.w), bfhi(kreg.w)}; float ss = 0.f;
#pragma unroll
            for (int i = 0; i < 8; ++i) ss += x[i] * x[i];
            ss += shx(ss, 1); ss += shx(ss, 2); ss += shx(ss, 4);
            const float rs = rsq(ss * (1.f / 64) + EPS); const int ch = tid & 7;
#pragma unroll
            for (int i = 0; i < 8; ++i) x[i] = x[i] * rs * gk[ch * 8 + i];
            stk16(Kt, f8_to_bf(x), tid); }
        stk16(Vt, vr[it], tid);
        __syncthreads();
        f32x16 s0, s1; float al; bf16x8 q0, q1, q2, q3; qk_tile<4>(s0, s1, Kt, 0, qf, r32, hi);
        softmax_tile(s0, s1, m, l, al, MaskNone{}, q0, q1, q2, q3);
        RESCALE(o0, o1, al);
        pv_tile_tr(o0, o1, q0, q1, q2, q3, Vt, lane);
    }
    __syncthreads();
    const float inv = 1.f / l;
    bf16* y = c.wsb(WS_XAO) + (size_t)row * 256 + h * 64;
#pragma unroll
    for (int q = 0; q < 4; ++q) { const int d = 8 * q + 4 * hi;
        u32x2 w0; w0.x = pk2(o0[4 * q] * inv, o0[4 * q + 1] * inv); w0.y = pk2(o0[4 * q + 2] * inv, o0[4 * q + 3] * inv); *(u32x2*)(y + d) = w0;
        u32x2 w1; w1.x = pk2(o1[4 * q] * inv, o1[4 * q + 1] * inv); w1.y = pk2(o1[4 * q + 2] * inv, o1[4 * q + 3] * inv); *(u32x2*)(y + 32 + d) = w1; }
}

DI void gdn_raw_load(const Ctx& c, int item, int tid, u32x4 (&rv)[4]) {
    const int n = item & 63, h = (item >> 6) & 3, b = item >> 8; const bf16* proj = c.wsb(WS_PROJ);
#pragma unroll
    for (int i = 0; i < 4; ++i) { const int e = tid + 512 * i; const int r = e / 24, rem = e % 24, seg = rem >> 3, c8 = rem & 7; const int tk = n * 64 + r - 3;
        const int col = (seg == 0 ? B_Q : (seg == 1 ? B_K : B_V)) + 64 * h + 8 * c8;
        rv[i] = (e < 67 * 24 && tk >= 0) ? *(const u32x4*)(proj + (size_t)(b * SEQ + tk) * PC + col) : (u32x4){0u, 0u, 0u, 0u}; }
}
DI void gdn_prep_item(const Ctx& c, int item, int item_next, u32x4 (&rv)[4]) {
    const int n = item & 63, h = (item >> 6) & 3, b = item >> 8; int tid = c.tid; asm volatile("" : "+v"(tid));
    LAS float* raw = (LAS float*)c.lds;
    LAS float* qs = raw + 67 * 192;
    LAS float* ks = qs + 64 * 65; LAS float* vs = ks + 64 * 65;
    LAS float* Am = vs + 64 * 65;
    LAS float* gcs = Am + 64 * 68; LAS float* betas = gcs + 64; LAS float* egc = betas + 64;
    const bf16* proj = c.wsb(WS_PROJ); const float* cw = c.in[9] + (size_t)c.l * 4 * 768;
    __syncthreads();
    for (int r5_ = 0; r5_ < (REP_PH == 45 ? 2 : 1); ++r5_) {
    __syncthreads();
    {
        if (REP_PH == 45 && r5_ > 0) gdn_raw_load(c, item, tid, rv);
#pragma unroll
        for (int i = 0; i < 4; ++i) { const int e = tid + 512 * i; const int r = e / 24, rem = e % 24, seg = rem >> 3, c8 = rem & 7;
            if (e < 67 * 24) { LAS float* p = raw + r * 192 + seg * 64 + 8 * c8;
                *(LAS f32x4*)p = (f32x4){bflo(rv[i].x), bfhi(rv[i].x), bflo(rv[i].y), bfhi(rv[i].y)}; *(LAS f32x4*)(p + 4) = (f32x4){bflo(rv[i].z), bfhi(rv[i].z), bflo(rv[i].w), bfhi(rv[i].w)}; } }
    }
    {
        const int d = tid & 63, rg = tid >> 6; float wq[4], wk[4], wv[4];
#pragma unroll
        for (int j = 0; j < 4; ++j) { wq[j] = cw[j * 768 + 64 * h + d]; wk[j] = cw[j * 768 + 256 + 64 * h + d]; wv[j] = cw[j * 768 + 512 + 64 * h + d]; }
        __syncthreads();
#pragma unroll
        for (int i = 0; i < 8; ++i) { const int r = rg + 8 * i; float aq = 0.f, ak = 0.f, av = 0.f;
#pragma unroll
            for (int j = 0; j < 4; ++j) { const LAS float* p = raw + (r + j) * 192 + d; aq += wq[j] * p[0]; ak += wk[j] * p[64]; av += wv[j] * p[128]; }
            qs[r * 65 + d] = silu(aq); ks[r * 65 + d] = silu(ak); vs[r * 65 + d] = silu(av); }
    }
    __syncthreads();
    {
        const int rw = tid >> 2, sub = tid & 3, r = rw & 63, which = rw >> 6; LAS float* arr = (which ? ks : qs) + r * 65 + 16 * sub; float x[16]; float ss = 0.f;
#pragma unroll
        for (int i = 0; i < 16; ++i) { x[i] = arr[i]; ss += x[i] * x[i]; }
        ss += shx(ss, 1); ss += shx(ss, 2);
        const float sc = rsq(ss + EPS) * (which ? 1.f : 0.125f);
#pragma unroll
        for (int i = 0; i < 16; ++i) { x[i] *= sc; arr[i] = x[i]; }
        LAS bf16* t16 = (LAS bf16*)raw + (which ? 0 : 64 * KP) + r * KP + 16 * sub;
        *(LAS u32x4*)t16 = (u32x4){pk2(x[0], x[1]), pk2(x[2], x[3]), pk2(x[4], x[5]), pk2(x[6], x[7])}; *(LAS u32x4*)(t16 + 8) = (u32x4){pk2(x[8], x[9]), pk2(x[10], x[11]), pk2(x[12], x[13]), pk2(x[14], x[15])};
    }
    if (tid >= 448) { const int cc = tid - 448; const bf16* pr = proj + (size_t)(b * SEQ + n * 64 + cc) * PC + SMC;
        const float a = bf2f(pr[12 + h]), bb = bf2f(pr[16 + h]);
        float g = -fexp(c.in[10][c.l * 4 + h]) * softplus_(a + c.in[11][c.l * 4 + h]);
#pragma unroll
        for (int o = 1; o < 64; o <<= 1) { const float t = shu(g, o); if (cc >= o) g += t; }
        gcs[cc] = g; betas[cc] = sigm(bb); egc[cc] = fexp(g); }
    __syncthreads();
    }
    const size_t ib = (size_t)item * 4096;
    bf16* Wg = c.ob16(OUT_GW) + ib; bf16* Ug = c.ob16(OUT_GW + 16 * MiB) + ib; bf16* QDg = c.ob16(OUT_GW + 32 * MiB) + ib; bf16* KETg = c.ob16(OUT_GW + 48 * MiB) + ib; bf16* ATTg = c.ob16(OUT_GW + 64 * MiB) + ib;
    {
        const int lane = tid & 63, w = __builtin_amdgcn_readfirstlane(tid >> 6), r32 = lane & 31, hi = lane >> 5; const int isqk = w >> 2, bi = (w >> 1) & 1, bj = w & 1;
        const LAS bf16* k16 = (const LAS bf16*)raw; const LAS bf16* a16 = isqk ? k16 + 64 * KP : k16;
        f32x16 acc;
#pragma unroll
        for (int i = 0; i < 16; ++i) acc[i] = 0.f;
        if (bj <= bi) {
#pragma unroll
            for (int s4 = 0; s4 < 4; ++s4) acc = MFMA32(*(const LAS bf16x8*)(a16 + (32 * bi + r32) * KP + 16 * s4 + 8 * hi), *(const LAS bf16x8*)(k16 + (32 * bj + r32) * KP + 16 * s4 + 8 * hi), acc); }
        const int j = 32 * bj + r32; const float gj = gcs[j];
#pragma unroll
        for (int rg_ = 0; rg_ < 16; ++rg_) { const int i = 32 * bi + crow(rg_, hi); const float dec = fexp(fminf(gcs[i] - gj, 0.f));
            if (isqk) ATTg[i * 64 + j] = f2bf((j <= i) ? acc[rg_] * dec : 0.f);
            else { const float av = (j < i) ? betas[i] * acc[rg_] * dec : 0.f; Am[i * 68 + j] = av; ((LAS bf16*)raw)[2 * 64 * KP + i * KP + j] = f2bf(av); } }
    }
    { const int ty = tid >> 4, tx = tid & 15, i0 = 2 * ty, j0 = 4 * tx; const float gl = gcs[63];
#pragma unroll
        for (int a = 0; a < 2; ++a) { const int i = i0 + a; const float ei = egc[i]; float qd[4], ke[4];
#pragma unroll
            for (int q = 0; q < 4; ++q) { const int j = j0 + q; qd[q] = qs[i * 65 + j] * ei; ke[q] = ks[j * 65 + i] * fexp(gl - gcs[j]); }
            u32x2 wv; wv.x = pk2(qd[0], qd[1]); wv.y = pk2(qd[2], qd[3]); *(u32x2*)(QDg + i * 64 + j0) = wv;
            wv.x = pk2(ke[0], ke[1]); wv.y = pk2(ke[2], ke[3]); *(u32x2*)(KETg + i * 64 + j0) = wv; }
        if (tid == 0) c.wsf(WS_GL)[item] = gl; }
    __syncthreads();
    if (item_next >= 0) gdn_raw_load(c, item_next, tid, rv);
    { LAS bf16* A16 = (LAS bf16*)raw + 2 * 64 * KP;
        LAS bf16* Ti16 = (LAS bf16*)raw + 3 * 64 * KP;
        LAS bf16* XT = (LAS bf16*)raw + 3 * 64 * KP + 4 * 16 * 40;
        LAS bf16* RT = (LAS bf16*)raw;
        if (tid >= 128 && tid < 192) { const int t = tid - 128, bk = t >> 4, j = t & 15; float y[16];
#pragma unroll
            for (int i = 0; i < 16; ++i) { float a0 = (i == j) ? 1.f : 0.f, a1 = 0.f;
#pragma unroll
                for (int k = 0; k < i; ++k) { const float av = Am[(16 * bk + i) * 68 + 16 * bk + k]; if (k & 1) a1 -= av * y[k]; else a0 -= av * y[k]; }
                y[i] = a0 + a1; Ti16[(bk * 16 + i) * 40 + j] = f2bf(y[i]); } }
        __syncthreads();
        const int lane = tid & 63, w = __builtin_amdgcn_readfirstlane(tid >> 6), l15 = lane & 15, g = lane >> 4; const int col = 16 * w + l15; const bool isw = w >= 4; const int cc = col & 63;
        bf16* dst = isw ? Wg : Ug; const bf16x8 zf = {0, 0, 0, 0, 0, 0, 0, 0};
#pragma unroll
        for (int bk = 0; bk < 4; ++bk) {
            f32x4 acc;
#pragma unroll
            for (int r = 0; r < 4; ++r) { const int i = 16 * bk + 4 * g + r; acc[r] = (isw ? ks[i * 65 + cc] * egc[i] : vs[i * 65 + cc]) * betas[i]; }
            if (bk > 0) { f32x4 upd = {0.f, 0.f, 0.f, 0.f};
#pragma unroll
                for (int ks_ = 0; ks_ < (16 * bk + 31) / 32; ++ks_) { const bool on = 32 * ks_ + 8 * g < 16 * bk;
                    const bf16x8 af = on ? *(const LAS bf16x8*)(A16 + (16 * bk + l15) * KP + 32 * ks_ + 8 * g) : zf;
                    const bf16x8 xf = on ? *(const LAS bf16x8*)(XT + col * KP + 32 * ks_ + 8 * g) : zf;
                    upd = __builtin_amdgcn_mfma_f32_16x16x32_bf16(af, xf, upd, 0, 0, 0); }
                acc = acc - upd; }
            { u32x2 pk; pk.x = pk2(acc[0], acc[1]); pk.y = pk2(acc[2], acc[3]); *(LAS u32x2*)(RT + col * 40 + 4 * g) = pk; }
            LDS_WAIT();
            const bf16x8 tf = (g < 2) ? *(const LAS bf16x8*)(Ti16 + (bk * 16 + l15) * 40 + 8 * g) : zf;
            const bf16x8 rf = (g < 2) ? *(const LAS bf16x8*)(RT + col * 40 + 8 * g) : zf;
            f32x4 x = {0.f, 0.f, 0.f, 0.f};
            x = __builtin_amdgcn_mfma_f32_16x16x32_bf16(tf, rf, x, 0, 0, 0);
            { u32x2 pk; pk.x = pk2(x[0], x[1]); pk.y = pk2(x[2], x[3]); *(LAS u32x2*)(XT + col * KP + 16 * bk + 4 * g) = pk; }
#pragma unroll
            for (int r = 0; r < 4; ++r) dst[(16 * bk + 4 * g + r) * 64 + cc] = f2bf(x[r]);
            LDS_WAIT();
        }
    }
}

constexpr int GT = 64 * KP * 2;
DI void gdn_scan_item(const Ctx& c, int bh, const float* gln) {
    const int b = bh >> 2, h = bh & 3; int tid = c.tid; asm volatile("" : "+v"(tid)); const int lane = tid & 63, w = __builtin_amdgcn_readfirstlane(tid >> 6), r32 = lane & 31, hi = lane >> 5;
    LAS bf16* Sb = (LAS bf16*)(c.lds + 10 * GT); LAS bf16* Vn = (LAS bf16*)(c.lds + 11 * GT); LAS float* ssb = (LAS float*)(c.lds + 12 * GT);
    const bool comp = w < 4; const int bi = (w >> 1) & 1, bj = w & 1;
    const bf16* gbase = c.ob16(OUT_GW) + (size_t)(bh * 64) * 4096;
    u32x4 lrA[5], lrB[5];
    f32x16 sreg;
#pragma unroll
    for (int i = 0; i < 16; ++i) sreg[i] = 0.f;
#define GDN_LOAD(SET, N) do { const bf16* gb_ = gbase + (size_t)(N) * 4096 + (tid >> 3) * 64 + (tid & 7) * 8; _Pragma("unroll") for (int t5 = 0; t5 < 5; ++t5) SET[t5] = *(const u32x4*)(gb_ + (size_t)t5 * (16 * MiB / 2)); } while (0)
#define GDN_STORE(SET, N) do { const int bo_ = ((N) & 1) * 5 * GT + ((tid >> 3) * KP + (tid & 7) * 8) * 2; _Pragma("unroll") for (int t5 = 0; t5 < 5; ++t5) *(LAS u32x4*)(c.lds + bo_ + t5 * GT) = SET[t5]; } while (0)
    __syncthreads();
    for (int i = tid; i < 64 * KP / 2; i += NTHREADS) ((LAS unsigned*)Sb)[i] = 0u;
    GDN_LOAD(lrA, 0); GDN_LOAD(lrB, 1); GDN_STORE(lrA, 0);
    __syncthreads();
    const int zc_row0 = b * SEQ + 32 * bj + r32; const bf16* zbase = c.wsb(WS_PROJ) + (size_t)zc_row0 * PC + B_Z + 64 * h + 32 * bi + 4 * hi;
    u32x2 zc[4], zn[4]; float glc = 0.f, gln_ = 0.f; LAS float* gls = ssb + 128;
    if (tid < 64) gls[tid] = gln[tid];
#pragma unroll
    for (int q = 0; q < 4; ++q) { zc[q] = (u32x2){0u, 0u}; zn[q] = (u32x2){0u, 0u}; }
#pragma unroll
    for (int q = 0; q < 4; ++q) zc[q] = *(const u32x2*)(zbase + 8 * q);
    glc = c.wsf(WS_GL)[bh * 64];
#define GDN_STEP(N, LS, WS, ZU, ZP, GU, GP) do { const int n = (N); \
        const int bufo = (n & 1) * 5 * GT; \
        const LAS bf16* Wt = (const LAS bf16*)(c.lds + bufo); const LAS bf16* Ut = (const LAS bf16*)(c.lds + bufo + GT); const LAS bf16* QDt = (const LAS bf16*)(c.lds + bufo + 2 * GT); \
        const LAS bf16* KETt = (const LAS bf16*)(c.lds + bufo + 3 * GT); const LAS bf16* ATTt = (const LAS bf16*)(c.lds + bufo + 4 * GT); \
        f32x16 o; \
        { const int n2_ = n + 2 < 64 ? n + 2 : 63; GDN_LOAD(LS, n2_); const int n1_ = n + 1 < 64 ? n + 1 : 63; \
          _Pragma("unroll") for (int q = 0; q < 4; ++q) ZP[q] = *(const u32x2*)(zbase + (size_t)n1_ * 64 * PC + 8 * q); GP = c.wsf(WS_GL)[bh * 64 + n1_]; } \
        if (comp) { \
            f32x16 t; _Pragma("unroll") for (int i = 0; i < 16; ++i) t[i] = 0.f; \
            _Pragma("unroll") for (int s = 0; s < 4; ++s) { const bf16x8 a = *(const LAS bf16x8*)(Sb + (32 * bi + r32) * KP + 16 * s + 8 * hi), bb = *(const LAS bf16x8*)(Wt + (32 * bj + r32) * KP + 16 * s + 8 * hi); t = MFMA32(a, bb, t); } \
            _Pragma("unroll") for (int q = 0; q < 4; ++q) { const u32x2 u4 = *(const LAS u32x2*)(Ut + (32 * bj + r32) * KP + 32 * bi + 8 * q + 4 * hi); \
                const float v0 = bflo(u4.x) - t[4 * q], v1 = bfhi(u4.x) - t[4 * q + 1], v2 = bflo(u4.y) - t[4 * q + 2], v3 = bfhi(u4.y) - t[4 * q + 3]; \
                LAS bf16* vp = Vn + (32 * bi + 8 * q + 4 * hi) * KP + 32 * bj + r32; \
                vp[0] = f2bf(v0); vp[KP] = f2bf(v1); vp[2 * KP] = f2bf(v2); vp[3 * KP] = f2bf(v3); } \
        } \
        __syncthreads(); \
        if (comp) { \
            _Pragma("unroll") for (int i = 0; i < 16; ++i) o[i] = 0.f; \
            _Pragma("unroll") for (int s = 0; s < 4; ++s) { const bf16x8 a = *(const LAS bf16x8*)(Sb + (32 * bi + r32) * KP + 16 * s + 8 * hi), bb = *(const LAS bf16x8*)(QDt + (32 * bj + r32) * KP + 16 * s + 8 * hi); o = MFMA32(a, bb, o); } \
            const float dec = fexp(GU); \
            f32x16 sn; _Pragma("unroll") for (int i = 0; i < 16; ++i) sn[i] = sreg[i] * dec; \
            _Pragma("unroll") for (int s = 0; s < 4; ++s) { const bf16x8 a = *(const LAS bf16x8*)(Vn + (32 * bi + r32) * KP + 16 * s + 8 * hi); \
                const bf16x8 b1 = *(const LAS bf16x8*)(ATTt + (32 * bj + r32) * KP + 16 * s + 8 * hi), b2 = *(const LAS bf16x8*)(KETt + (32 * bj + r32) * KP + 16 * s + 8 * hi); \
                o = MFMA32(a, b1, o); sn = MFMA32(a, b2, sn); } \
            sreg = sn; \
            float sq = 0.f; _Pragma("unroll") for (int i = 0; i < 16; ++i) sq += o[i] * o[i]; \
            sq += shx(sq, 32); \
            if (hi == 0) ssb[bi * 64 + 32 * bj + r32] = sq; \
        } \
        __syncthreads(); \
        if (comp) { \
            _Pragma("unroll") for (int i = 0; i < 16; ++i) Sb[(32 * bi + crow(i, hi)) * KP + 32 * bj + r32] = f2bf(sreg[i]); \
            const int cc = 32 * bj + r32; const float rs = rsq((ssb[cc] + ssb[64 + cc]) * (1.f / 64) + EPS); \
            const int row = b * SEQ + n * 64 + cc; bf16* yp = c.wsb(WS_HN) + (size_t)row * DM + 256 + 64 * h; \
            _Pragma("unroll") for (int q = 0; q < 4; ++q) { const int dv = 32 * bi + 8 * q + 4 * hi; const u32x2 z = ZU[q]; const f32x4 g = *(const LAS f32x4*)(gls + dv); \
                u32x2 wv; wv.x = pk2(o[4 * q] * rs * g[0] * silu(bflo(z.x)), o[4 * q + 1] * rs * g[1] * silu(bfhi(z.x))); \
                wv.y = pk2(o[4 * q + 2] * rs * g[2] * silu(bflo(z.y)), o[4 * q + 3] * rs * g[3] * silu(bfhi(z.y))); *(u32x2*)(yp + dv) = wv; } \
        } \
        GDN_STORE(WS, n + 1); \
        __syncthreads(); } while (0)
#pragma unroll 1
    for (int n2 = 0; n2 < 64; n2 += 2) { GDN_STEP(n2, lrA, lrB, zc, zn, glc, gln_); GDN_STEP(n2 + 1, lrB, lrA, zn, zc, gln_, glc); }
#undef GDN_STEP
#undef GDN_LOAD
#undef GDN_STORE
}

constexpr float MKS = 0.17677669529663687f;
DI void mlstm_gates(const Ctx& c, int b, int h, int n, int lane, float& ig, float& bcum) {
    const bf16* pr = c.wsb(WS_PROJ) + (size_t)(b * SEQ + n * 64 + lane) * PC + SMC;
    const float ip = bf2f(pr[20 + h]) + c.in[13][c.l * 4 + h], fp = bf2f(pr[24 + h]) + c.in[14][c.l * 4 + h];
    ig = 15.f * tanh_(ip * (1.f / 15.f)); float lf = -softplus_(-15.f * tanh_(fp * (1.f / 15.f)));
#pragma unroll
    for (int o = 1; o < 64; o <<= 1) { const float t = shu(lf, o); if (lane >= o) lf += t; }
    bcum = lf;
}
DI void mlstm_prep_item(const Ctx& c, int item) {
    const int n = item & 63, h = (item >> 6) & 3, b = item >> 8; int tid = c.tid; asm volatile("" : "+v"(tid));
    LAS float* kk = (LAS float*)c.lds; LAS float* vv = kk + 64 * 33; LAS float* wend = vv + 64 * 65;
    const bf16* proj = c.wsb(WS_PROJ);
    __syncthreads();
    for (int e = tid; e < 64 * 32; e += NTHREADS) { const int r = e >> 5, d = e & 31; kk[r * 33 + d] = bf2f(proj[(size_t)(b * SEQ + n * 64 + r) * PC + C_K + 32 * h + d]) * MKS; }
    for (int e = tid; e < 64 * 64; e += NTHREADS) { const int r = e >> 6, d = e & 63; vv[r * 65 + d] = bf2f(proj[(size_t)(b * SEQ + n * 64 + r) * PC + C_V + 64 * h + d]); }
    if (tid < 64) { float ig, bc; mlstm_gates(c, b, h, n, tid, ig, bc); const float bl = __builtin_bit_cast(float, __builtin_amdgcn_readlane(__builtin_bit_cast(int, bc), 63)); const float ae = bl - bc + ig; const float ml = wmax(ae);
        wend[tid] = fexp(ae - ml); if (tid == 0) { c.wsf(WS_MLOC)[item] = ml; c.wsf(WS_BLAST)[item] = bl; } }
    __syncthreads();
    { const int dv = tid >> 3, dk0 = (tid & 7) * 4; float a[4] = {0.f, 0.f, 0.f, 0.f};
        for (int r = 0; r < 64; ++r) { const float wv = wend[r] * vv[r * 65 + dv];
#pragma unroll
            for (int q = 0; q < 4; ++q) a[q] += wv * kk[r * 33 + dk0 + q]; }
        *(f32x4*)(c.of32(OUT_CLOC) + (size_t)item * 2048 + dv * 32 + dk0) = (f32x4){a[0], a[1], a[2], a[3]}; }
    if (tid < 32) { float a = 0.f; for (int r = 0; r < 64; ++r) a += wend[r] * kk[r * 33 + tid]; c.wsf(WS_NLOC)[(size_t)item * 32 + tid] = a; }
}
DI void mlstm_scan_item(const Ctx& c, int bh) {
    int tid = c.tid; asm volatile("" : "+v"(tid)); f32x4 cs = {0.f, 0.f, 0.f, 0.f}; float ns = 0.f, ms = 0.f;
    for (int n = 0; n < 64; ++n) { const size_t it = (size_t)bh * 64 + n;
        const f32x4 cl = *(const f32x4*)(c.of32(OUT_CLOC) + it * 2048 + tid * 4); const float nl = (tid < 32) ? c.wsf(WS_NLOC)[it * 32 + tid] : 0.f;
        const float ml = c.wsf(WS_MLOC)[it], bl = c.wsf(WS_BLAST)[it];
        *(f32x4*)(c.of32(OUT_CIN) + it * 2048 + tid * 4) = cs; if (tid < 32) c.wsf(WS_NIN)[it * 32 + tid] = ns; if (tid == 0) c.wsf(WS_MIN)[it] = ms;
        const float mn = fmaxf(bl + ms, ml), sp = fexp(bl + ms - mn), sl = fexp(ml - mn);
        cs = cs * sp + cl * sl; ns = ns * sp + nl * sl; ms = mn; }
}
DI void mlstm_out_item(const Ctx& c, int item) {
    const int n = item & 63, h = (item >> 6) & 3, b = item >> 8; int tid = c.tid; asm volatile("" : "+v"(tid));
    LAS float* qq = (LAS float*)c.lds; LAS float* kk = qq + 64 * 33; LAS float* vv = kk + 64 * 33; LAS float* cin = vv + 64 * 65; LAS float* Wm = cin + 64 * 33;
    LAS float* bcs = Wm + 64 * 65; LAS float* igs = bcs + 64; LAS float* mts = igs + 64; LAS float* wint = mts + 64; LAS float* nin = wint + 64;
    const bf16* proj = c.wsb(WS_PROJ);
    __syncthreads();
    for (int e = tid; e < 64 * 32; e += NTHREADS) { const int r = e >> 5, d = e & 31; const bf16* pr = proj + (size_t)(b * SEQ + n * 64 + r) * PC;
        qq[r * 33 + d] = bf2f(pr[C_Q + 32 * h + d]); kk[r * 33 + d] = bf2f(pr[C_K + 32 * h + d]) * MKS; }
    for (int e = tid; e < 64 * 64; e += NTHREADS) { const int r = e >> 6, d = e & 63; vv[r * 65 + d] = bf2f(proj[(size_t)(b * SEQ + n * 64 + r) * PC + C_V + 64 * h + d]); }
    for (int e = tid; e < 64 * 32; e += NTHREADS) { const int dv = e >> 5, dk = e & 31; cin[dv * 33 + dk] = c.of32(OUT_CIN)[(size_t)item * 2048 + e]; }
    if (tid < 32) nin[tid] = c.wsf(WS_NIN)[(size_t)item * 32 + tid];
    if (tid < 64) { float ig, bc; mlstm_gates(c, b, h, n, tid, ig, bc); float pm = ig - bc;
#pragma unroll
        for (int o = 1; o < 64; o <<= 1) { const float t = shu(pm, o); if (tid >= o) pm = fmaxf(pm, t); }
        const float mi = c.wsf(WS_MIN)[item]; const float mt = bc + fmaxf(mi, pm);
        bcs[tid] = bc; igs[tid] = ig; mts[tid] = mt; wint[tid] = fexp(bc + mi - mt); }
    __syncthreads();
    const int ty = tid >> 4, tx = tid & 15, i0 = 2 * ty, j0 = 4 * tx;
    { float qk[2][4];
#pragma unroll
        for (int a = 0; a < 2; ++a)
#pragma unroll
            for (int q = 0; q < 4; ++q) qk[a][q] = 0.f;
        for (int k = 0; k < 32; ++k) { const float q0 = qq[i0 * 33 + k], q1 = qq[(i0 + 1) * 33 + k];
#pragma unroll
            for (int q = 0; q < 4; ++q) { const float kj = kk[(j0 + q) * 33 + k]; qk[0][q] += q0 * kj; qk[1][q] += q1 * kj; } }
#pragma unroll
        for (int a = 0; a < 2; ++a) { const int i = i0 + a;
#pragma unroll
            for (int q = 0; q < 4; ++q) { const int s = j0 + q; Wm[i * 65 + s] = (s <= i) ? fexp(bcs[i] - bcs[s] + igs[s] - mts[i]) * qk[a][q] : 0.f; } } }
    __syncthreads();
    { float num[2][4], rsum[2] = {0.f, 0.f}, inter[2][4], qn[2] = {0.f, 0.f};
#pragma unroll
        for (int a = 0; a < 2; ++a)
#pragma unroll
            for (int q = 0; q < 4; ++q) { num[a][q] = 0.f; inter[a][q] = 0.f; }
        for (int s = 0; s < 64; ++s) { const float w0 = Wm[i0 * 65 + s], w1 = Wm[(i0 + 1) * 65 + s]; rsum[0] += w0; rsum[1] += w1;
#pragma unroll
            for (int q = 0; q < 4; ++q) { const float ve = vv[s * 65 + j0 + q]; num[0][q] += w0 * ve; num[1][q] += w1 * ve; } }
        for (int k = 0; k < 32; ++k) { const float q0 = qq[i0 * 33 + k], q1 = qq[(i0 + 1) * 33 + k], nk = nin[k]; qn[0] += q0 * nk; qn[1] += q1 * nk;
#pragma unroll
            for (int q = 0; q < 4; ++q) { const float ce = cin[(j0 + q) * 33 + k]; inter[0][q] += q0 * ce; inter[1][q] += q1 * ce; } }
        const float* ng = c.in[15] + (size_t)c.l * 64;
#pragma unroll
        for (int a = 0; a < 2; ++a) { const int i = i0 + a; const float wi = wint[i]; const float den = wi * qn[a] + rsum[a]; const float dd = fmaxf(fabsf(den), fexp(-mts[i])); const float inv = 1.f / dd;
            float hv[4]; float ss = 0.f;
#pragma unroll
            for (int q = 0; q < 4; ++q) { hv[q] = (wi * inter[a][q] + num[a][q]) * inv; ss += hv[q] * hv[q]; }
            ss += shx(ss, 1); ss += shx(ss, 2); ss += shx(ss, 4); ss += shx(ss, 8);
            const float rs = rsq(ss * (1.f / 64) + EPS); const int row = b * SEQ + n * 64 + i;
            const u32x2 op = *(const u32x2*)(proj + (size_t)row * PC + C_O + 64 * h + j0); const f32x4 g = *(const f32x4*)(ng + j0);
            u32x2 wv; wv.x = pk2(hv[0] * rs * g[0] * sigm(bflo(op.x)), hv[1] * rs * g[1] * sigm(bfhi(op.x))); wv.y = pk2(hv[2] * rs * g[2] * sigm(bflo(op.y)), hv[3] * rs * g[3] * sigm(bfhi(op.y)));
            *(u32x2*)(c.wsb(WS_HN) + (size_t)row * DM + 512 + 64 * h + j0) = wv; } }
}

DI void mlstm_prep_mf(const Ctx& c, int item2) {
    const int n = item2 & 63, b = item2 >> 6; int tid = c.tid; asm volatile("" : "+v"(tid)); const int lane = tid & 63, w = __builtin_amdgcn_readfirstlane(tid >> 6), r32 = lane & 31, hi = lane >> 5;
    constexpr int VTW = 64 * VP * 2, KTT = 32 * KP * 2, HB = VTW + KTT + 256;
    const bf16* proj = c.wsb(WS_PROJ); const int row0 = b * SEQ + n * 64;
    __syncthreads();
    if (w < 4) { const int h = w; float ig, bc; mlstm_gates(c, b, h, n, lane, ig, bc); const float bl = __builtin_bit_cast(float, __builtin_amdgcn_readlane(__builtin_bit_cast(int, bc), 63)); const float ae = bl - bc + ig; const float ml = wmax(ae);
        ((LAS float*)(c.lds + h * HB + VTW + KTT))[lane] = fexp(ae - ml);
        if (lane == 0) { const int it = (b * 4 + h) * 64 + n; c.wsf(WS_MLOC)[it] = ml; c.wsf(WS_BLAST)[it] = bl; } }
    __syncthreads();
    { const int cc = tid & 63;
        u32x4 vv[4], kv[2];
#pragma unroll
        for (int i = 0; i < 4; ++i) { const int idx = (tid >> 6) + 8 * i; vv[i] = *(const u32x4*)(proj + (size_t)(row0 + cc) * PC + C_V + 8 * idx); }
#pragma unroll
        for (int i = 0; i < 2; ++i) { const int idx = (tid >> 6) + 8 * i; kv[i] = *(const u32x4*)(proj + (size_t)(row0 + cc) * PC + C_K + 8 * idx); }
#pragma unroll
        for (int i = 0; i < 4; ++i) { const int idx = (tid >> 6) + 8 * i, h = idx >> 3, ch = idx & 7; const float we = ((const LAS float*)(c.lds + h * HB + VTW + KTT))[cc];
            LAS bf16* p = (LAS bf16*)(c.lds + h * HB) + (8 * ch) * VP + cc; const u32x4 v = vv[i];
            p[0] = f2bf(bflo(v.x) * we); p[VP] = f2bf(bfhi(v.x) * we); p[2 * VP] = f2bf(bflo(v.y) * we); p[3 * VP] = f2bf(bfhi(v.y) * we);
            p[4 * VP] = f2bf(bflo(v.z) * we); p[5 * VP] = f2bf(bfhi(v.z) * we); p[6 * VP] = f2bf(bflo(v.w) * we); p[7 * VP] = f2bf(bfhi(v.w) * we); }
#pragma unroll
        for (int i = 0; i < 2; ++i) { const int idx = (tid >> 6) + 8 * i, h = idx >> 2, ch = idx & 3;
            LAS bf16* p = (LAS bf16*)(c.lds + h * HB + VTW) + (8 * ch) * KP + cc; const u32x4 v = kv[i];
            p[0] = (bf16)(v.x & 0xffffu); p[KP] = (bf16)(v.x >> 16); p[2 * KP] = (bf16)(v.y & 0xffffu); p[3 * KP] = (bf16)(v.y >> 16);
            p[4 * KP] = (bf16)(v.z & 0xffffu); p[5 * KP] = (bf16)(v.z >> 16); p[6 * KP] = (bf16)(v.w & 0xffffu); p[7 * KP] = (bf16)(v.w >> 16); }
    }
    __syncthreads();
    { const int h = w >> 1, blk = w & 1; const int it = (b * 4 + h) * 64 + n;
        const LAS bf16* Vw = (const LAS bf16*)(c.lds + h * HB); const LAS bf16* Kx = (const LAS bf16*)(c.lds + h * HB + VTW); const LAS float* we = (const LAS float*)(c.lds + h * HB + VTW + KTT);
        f32x16 acc;
#pragma unroll
        for (int i = 0; i < 16; ++i) acc[i] = 0.f;
#pragma unroll
        for (int s = 0; s < 4; ++s) { const LAS bf16* ap = Vw + (32 * blk + r32) * VP + 16 * s + 8 * hi;
            const u32x2 lo = *(const LAS u32x2*)ap, hi2 = *(const LAS u32x2*)(ap + 4); u32x4 af; af.x = lo.x; af.y = lo.y; af.z = hi2.x; af.w = hi2.y;
            const bf16x8 bfm = *(const LAS bf16x8*)(Kx + r32 * KP + 16 * s + 8 * hi);
            acc = MFMA32(__builtin_bit_cast(bf16x8, af), bfm, acc); }
        float* dst = c.of32(OUT_CLOC) + (size_t)it * 2048;
#pragma unroll
        for (int i = 0; i < 16; ++i) dst[(32 * blk + crow(i, hi)) * 32 + r32] = acc[i] * MKS;
        if (blk == 0 && lane < 32) { float a = 0.f;
#pragma unroll 8
            for (int cc = 0; cc < 64; ++cc) a += we[cc] * bf2f(Kx[lane * KP + cc]);
            c.wsf(WS_NLOC)[(size_t)it * 32 + lane] = a * MKS; }
    }
}
DI void mlstm_out_mf(const Ctx& c, int item2) {
    const int n = item2 & 63, b = item2 >> 6; int tid = c.tid; asm volatile("" : "+v"(tid)); const int lane = tid & 63, w = __builtin_amdgcn_readfirstlane(tid >> 6), r32 = lane & 31, hi = lane >> 5;
    constexpr int KTB = 64 * 40 * 2, VTB = 64 * VP * 2, CTB = 64 * 40 * 2, HB = KTB + VTB + CTB + 5 * 256;
    const bf16* proj = c.wsb(WS_PROJ); const int row0 = b * SEQ + n * 64;
    __syncthreads();
    if (w < 4) { const int h = w; const int it = (b * 4 + h) * 64 + n; float ig, bc; mlstm_gates(c, b, h, n, lane, ig, bc); float pm = ig - bc; const float dsv = pm;
#pragma unroll
        for (int o = 1; o < 64; o <<= 1) { const float t = shu(pm, o); if (lane >= o) pm = fmaxf(pm, t); }
        const float mi = c.wsf(WS_MIN)[it]; const float mt = bc + fmaxf(mi, pm);
        LAS float* ga = (LAS float*)(c.lds + h * HB + KTB + VTB + CTB);
        ga[lane] = bc; ga[64 + lane] = dsv; ga[128 + lane] = mt; ga[192 + lane] = fexp(bc + mi - mt); if (lane < 32) ga[256 + lane] = c.wsf(WS_NIN)[(size_t)it * 32 + lane]; }
    { const int cc = tid & 63;
        u32x4 vv[4], kv[2]; f32x4 cv[4];
#pragma unroll
        for (int i = 0; i < 4; ++i) { const int idx = (tid >> 6) + 8 * i; vv[i] = *(const u32x4*)(proj + (size_t)(row0 + cc) * PC + C_V + 8 * idx); }
#pragma unroll
        for (int i = 0; i < 2; ++i) { const int e = tid + 512 * i; const int s_ = e >> 4, q = e & 15; kv[i] = *(const u32x4*)(proj + (size_t)(row0 + s_) * PC + C_K + 8 * q); }
#pragma unroll
        for (int i = 0; i < 4; ++i) { const int e = tid + 512 * i; const int h = e >> 9, q = e & 511; cv[i] = *(const f32x4*)(c.of32(OUT_CIN) + (size_t)((b * 4 + h) * 64 + n) * 2048 + 4 * q); }
#pragma unroll
        for (int i = 0; i < 4; ++i) { const int idx = (tid >> 6) + 8 * i, h = idx >> 3, ch = idx & 7;
            LAS bf16* p = (LAS bf16*)(c.lds + h * HB + KTB) + (8 * ch) * VP + cc; const u32x4 v = vv[i];
            p[0] = (bf16)(v.x & 0xffffu); p[VP] = (bf16)(v.x >> 16); p[2 * VP] = (bf16)(v.y & 0xffffu); p[3 * VP] = (bf16)(v.y >> 16);
            p[4 * VP] = (bf16)(v.z & 0xffffu); p[5 * VP] = (bf16)(v.z >> 16); p[6 * VP] = (bf16)(v.w & 0xffffu); p[7 * VP] = (bf16)(v.w >> 16); }
#pragma unroll
        for (int i = 0; i < 2; ++i) { const int e = tid + 512 * i; const int s_ = e >> 4, q = e & 15, h = q >> 2, ch = q & 3;
            *(LAS u32x4*)((LAS bf16*)(c.lds + h * HB) + s_ * 40 + 8 * ch) = kv[i]; }
#pragma unroll
        for (int i = 0; i < 4; ++i) { const int e = tid + 512 * i; const int h = e >> 9, q = e & 511, ev = q >> 3, dk = (q & 7) * 4;
            u32x2 pkd; pkd.x = pk2(cv[i][0], cv[i][1]); pkd.y = pk2(cv[i][2], cv[i][3]);
            *(LAS u32x2*)((LAS bf16*)(c.lds + h * HB + KTB + VTB) + ev * 40 + dk) = pkd; }
    }
    __syncthreads();
    { const int h = w >> 1, chf = w & 1; const int cl = 32 * chf + r32, row = row0 + cl;
        const LAS bf16* Kt = (const LAS bf16*)(c.lds + h * HB); const LAS bf16* Vt = (const LAS bf16*)(c.lds + h * HB + KTB); const LAS bf16* Ct = (const LAS bf16*)(c.lds + h * HB + KTB + VTB);
        const LAS float* ga = (const LAS float*)(c.lds + h * HB + KTB + VTB + CTB);
        bf16x8 qf[2];
#pragma unroll
        for (int ks = 0; ks < 2; ++ks) qf[ks] = *(const bf16x8*)(proj + (size_t)row * PC + C_Q + 32 * h + 16 * ks + 8 * hi);
        const float bc_c = ga[cl], mt_c = ga[128 + cl], wi_c = ga[192 + cl];
        f32x16 x0, x1;
#pragma unroll
        for (int i = 0; i < 16; ++i) { x0[i] = 0.f; x1[i] = 0.f; }
#pragma unroll
        for (int ks = 0; ks < 2; ++ks) { x0 = MFMA32(*(const LAS bf16x8*)(Kt + r32 * 40 + 16 * ks + 8 * hi), qf[ks], x0); }
        if (chf) {
#pragma unroll
            for (int ks = 0; ks < 2; ++ks) x1 = MFMA32(*(const LAS bf16x8*)(Kt + (32 + r32) * 40 + 16 * ks + 8 * hi), qf[ks], x1); }
        float rsum = 0.f; const float e0 = bc_c - mt_c;
#pragma unroll
        for (int i = 0; i < 16; ++i) { const int s0 = crow(i, hi), s1 = 32 + s0;
            const float w0 = (s0 <= cl) ? fexp(e0 + ga[64 + s0]) * x0[i] * MKS : 0.f; const float w1 = (s1 <= cl) ? fexp(e0 + ga[64 + s1]) * x1[i] * MKS : 0.f;
            x0[i] = w0; x1[i] = w1; rsum += w0 + w1; }
        rsum += shx(rsum, 32);
        f32x16 n0, n1;
#pragma unroll
        for (int i = 0; i < 16; ++i) { n0[i] = 0.f; n1[i] = 0.f; }
        pv_tile(n0, n1, pack8(x0, 0), pack8(x0, 1), pack8(x1, 0), pack8(x1, 1), Vt, r32, hi);
        f32x16 i0, i1;
#pragma unroll
        for (int i = 0; i < 16; ++i) { i0[i] = 0.f; i1[i] = 0.f; }
#pragma unroll
        for (int ks = 0; ks < 2; ++ks) { i0 = MFMA32(*(const LAS bf16x8*)(Ct + r32 * 40 + 16 * ks + 8 * hi), qf[ks], i0); i1 = MFMA32(*(const LAS bf16x8*)(Ct + (32 + r32) * 40 + 16 * ks + 8 * hi), qf[ks], i1); }
        float qn = 0.f;
#pragma unroll
        for (int ks = 0; ks < 2; ++ks) { const u32x4 qq = __builtin_bit_cast(u32x4, qf[ks]); const LAS float* np = ga + 256 + 16 * ks + 8 * hi;
            qn += bflo(qq.x) * np[0] + bfhi(qq.x) * np[1] + bflo(qq.y) * np[2] + bfhi(qq.y) * np[3] + bflo(qq.z) * np[4] + bfhi(qq.z) * np[5] + bflo(qq.w) * np[6] + bfhi(qq.w) * np[7]; }
        qn += shx(qn, 32);
        const float den = wi_c * qn + rsum; const float inv = 1.f / fmaxf(fabsf(den), fexp(-mt_c));
        float ss = 0.f;
#pragma unroll
        for (int i = 0; i < 16; ++i) { n0[i] = (wi_c * i0[i] + n0[i]) * inv; n1[i] = (wi_c * i1[i] + n1[i]) * inv; ss += n0[i] * n0[i] + n1[i] * n1[i]; }
        ss += shx(ss, 32);
        const float rs = rsq(ss * (1.f / 64) + EPS); const float* ng = c.in[15] + (size_t)c.l * 64;
        const bf16* op = proj + (size_t)row * PC + C_O + 64 * h; bf16* y = c.wsb(WS_HN) + (size_t)row * DM + 512 + 64 * h;
#pragma unroll
        for (int q = 0; q < 4; ++q) { const int d = 8 * q + 4 * hi; const f32x4 g0 = *(const f32x4*)(ng + d), g1 = *(const f32x4*)(ng + 32 + d); const u32x2 o0 = *(const u32x2*)(op + d), o1 = *(const u32x2*)(op + 32 + d);
            u32x2 w0; w0.x = pk2(n0[4 * q] * rs * g0[0] * sigm(bflo(o0.x)), n0[4 * q + 1] * rs * g0[1] * sigm(bfhi(o0.x))); w0.y = pk2(n0[4 * q + 2] * rs * g0[2] * sigm(bflo(o0.y)), n0[4 * q + 3] * rs * g0[3] * sigm(bfhi(o0.y))); *(u32x2*)(y + d) = w0;
            u32x2 w1; w1.x = pk2(n1[4 * q] * rs * g1[0] * sigm(bflo(o1.x)), n1[4 * q + 1] * rs * g1[1] * sigm(bfhi(o1.x))); w1.y = pk2(n1[4 * q + 2] * rs * g1[2] * sigm(bflo(o1.y)), n1[4 * q + 3] * rs * g1[3] * sigm(bfhi(o1.y))); *(u32x2*)(y + 32 + d) = w1; }
    }
}

DI void phase_norm_route(const Ctx& c, bool dry) {
    constexpr int WP = 1032;
    LAS bf16* wl = (LAS bf16*)c.lds;
    LAS float* lg = (LAS float*)(c.lds + 48 * WP * 2) + c.wave * (16 * 52);
    LAS int* hist = (LAS int*)(c.lds + 48 * WP * 2 + 8 * 16 * 52 * 4);
    bf16* hn = c.wsb(WS_HN);
    const bf16* whi = c.wsb(WS_WRT) + (size_t)(c.l * 2) * 65536;
    const float* bg = c.in[27] + c.l * 4; const float* be = c.in[29] + c.l * 32;
    const int t16 = c.lane & 15, g = c.lane >> 4;
    __syncthreads();
    for (int i = c.tid; i < 48 * 128; i += NTHREADS) { const int e = i >> 7, ch = i & 127; *(LAS u32x4*)(wl + e * WP + 8 * ch) = *(const u32x4*)(whi + (size_t)e * 1024 + 8 * ch); }
    for (int tile = c.gw; tile < T / 16; tile += c.ngw) {
        __syncthreads();
        if (c.tid < 32) hist[c.tid] = 0;
        __syncthreads();
        const int row = 16 * tile + t16; const bf16* hp = c.wsb(WS_RES) + (size_t)row * DM + 8 * g;
        const LAS bf16* wr = wl + t16 * WP + 8 * g;
        f32x4 a0 = {0.f, 0.f, 0.f, 0.f}, a1 = a0, a2 = a0;
        float ss = 0.f;
#pragma unroll 8
        for (int s = 0; s < 32; ++s) {
            const u32x4 ph = *(const u32x4*)(hp + 32 * s);
            const bf16x8 h0 = *(const LAS bf16x8*)(wr + 32 * s), h1 = *(const LAS bf16x8*)(wr + 16 * WP + 32 * s), h2 = *(const LAS bf16x8*)(wr + 32 * WP + 32 * s);
            { const float x0 = bflo(ph.x), x1 = bfhi(ph.x), x2 = bflo(ph.y), x3 = bfhi(ph.y), x4 = bflo(ph.z), x5 = bfhi(ph.z), x6 = bflo(ph.w), x7 = bfhi(ph.w);
              ss += (x0 * x0 + x1 * x1) + (x2 * x2 + x3 * x3) + (x4 * x4 + x5 * x5) + (x6 * x6 + x7 * x7); }
            const bf16x8 xh = __builtin_bit_cast(bf16x8, ph);
            a0 = __builtin_amdgcn_mfma_f32_16x16x32_bf16(h0, xh, a0, 0, 0, 0);
            a1 = __builtin_amdgcn_mfma_f32_16x16x32_bf16(h1, xh, a1, 0, 0, 0);
            a2 = __builtin_amdgcn_mfma_f32_16x16x32_bf16(h2, xh, a2, 0, 0, 0);
        }
        ss += shx(ss, 16); ss += shx(ss, 32);
        const float rs = rsq(ss * (1.f / DM) + EPS);
        if (g == 0) c.wsf(WS_RS)[row] = rs;
#pragma unroll
        for (int r = 0; r < 4; ++r) { lg[t16 * 52 + 4 * g + r] = a0[r] * rs; lg[t16 * 52 + 16 + 4 * g + r] = a1[r] * rs; lg[t16 * 52 + 32 + 4 * g + r] = a2[r] * rs; }
        LDS_WAIT();
        if (c.lane < 16) { const LAS float* Lg = lg + c.lane * 52;
            int gi = 0; float gm = Lg[0] + bg[0];
            for (int i = 1; i < 4; ++i) { const float v = Lg[i] + bg[i]; if (v > gm) { gm = v; gi = i; } }
            float gs = 0.f; for (int i = 0; i < 4; ++i) gs += fexp(Lg[i] + bg[i] - gm);
            const float gp = 1.f / gs;
            int i1 = 0; float m1 = -1e30f, m2 = -1e30f; int i2 = 0;
            for (int i = 0; i < 8; ++i) { const float v = Lg[4 + gi * 8 + i] + be[gi * 8 + i]; if (v > m1) { m2 = m1; i2 = i1; m1 = v; i1 = i; } else if (v > m2) { m2 = v; i2 = i; } }
            const float p2 = fexp(m2 - m1); const float w1_ = gp / (1.f + p2), w2_ = gp * p2 / (1.f + p2);
            const int e1 = gi * 8 + i1, e2 = gi * 8 + i2; const int rw = 16 * tile + c.lane;
            c.wsi(WS_TOKE)[2 * rw] = e1; c.wsi(WS_TOKE)[2 * rw + 1] = e2; c.wsf(WS_TOKW)[2 * rw] = w1_; c.wsf(WS_TOKW)[2 * rw + 1] = w2_;
            __hip_atomic_fetch_add(hist + e1, 1, __ATOMIC_RELAXED, __HIP_MEMORY_SCOPE_WORKGROUP); __hip_atomic_fetch_add(hist + e2, 1, __ATOMIC_RELAXED, __HIP_MEMORY_SCOPE_WORKGROUP); }
        __syncthreads();
        if (c.tid < 32) c.wsi(WS_BLKCNT)[(tile >> 3) * 32 + c.tid] = hist[c.tid];
    }
    (void)dry;
}
DI void moe_tiles(const Ctx& c, LAS int* tb, LAS unsigned char* t2e, const LAS int* ltot = nullptr) {
    __syncthreads();
    if (c.tid < 64) { const int n = (c.tid < 32) ? ((ltot ? ltot[c.tid] : c.wsi(WS_MCNT)[c.tid]) + 255) >> 8 : 0; int inc = n;
#pragma unroll
        for (int o = 1; o < 32; o <<= 1) { const int t = shu(inc, o); if (c.tid >= o) inc += t; }
        if (c.tid < 32) tb[c.tid] = inc - n; if (c.tid == 31) tb[32] = inc; }
    __syncthreads();
    if (c.tid < 320) { int e = 0;
#pragma unroll 1
        for (int k = 1; k < 32; ++k) if (c.tid >= tb[k]) e = k;
        t2e[c.tid] = (unsigned char)e; }
    __syncthreads();
}
DI void phase_moe_slots(const Ctx& c, bool dry) {
    LAS int* tb = (LAS int*)(c.lds + LDS_MISC + 64); LAS unsigned char* t2e = (LAS unsigned char*)(c.lds + LDS_MISC + 256);
    LAS int* lcnt = (LAS int*)(c.lds); LAS int* lbase = lcnt + 32; LAS int* ltot = lcnt + 64; LAS int* ptot = lcnt + 128; LAS int* ppre = ptot + 512;
    (void)dry;
    const int* bc = c.wsi(WS_BLKCNT);
    for (int blk = c.blk; blk < 256; blk += c.G) {
        __syncthreads();
        {
            const int e = c.tid & 31, part = c.tid >> 5; int v[16]; int tsum = 0, psum = 0;
#pragma unroll
            for (int i = 0; i < 16; ++i) v[i] = bc[(part * 16 + i) * 32 + e];
#pragma unroll
            for (int i = 0; i < 16; ++i) { tsum += v[i]; psum += (part * 16 + i < blk) ? v[i] : 0; }
            ptot[part * 32 + e] = tsum; ppre[part * 32 + e] = psum; }
        if (c.tid < 32) lcnt[c.tid] = 0;
        __syncthreads();
        if (c.tid < 32) { int t_ = 0, p_ = 0;
#pragma unroll
            for (int k = 0; k < 16; ++k) { t_ += ptot[k * 32 + c.tid]; p_ += ppre[k * 32 + c.tid]; }
            ltot[c.tid] = t_; lbase[c.tid] = p_; if (blk == 0) c.wsi(WS_MCNT)[c.tid] = t_; }
        moe_tiles(c, tb, t2e, ltot);
        int e = 0, rank = 0, token = 0, which = 0;
        if (c.tid < 256) { token = blk * 128 + (c.tid >> 1); which = c.tid & 1; e = c.wsi(WS_TOKE)[2 * token + which]; rank = __hip_atomic_fetch_add(lcnt + e, 1, __ATOMIC_RELAXED, __HIP_MEMORY_SCOPE_WORKGROUP); }
        __syncthreads();
        if (c.tid < 256) { const int slot = 256 * tb[e] + lbase[e] + rank; c.wsi(WS_SLOTTOK)[slot] = token; c.wsi(WS_TOKS)[2 * token + which] = slot; }
        if (blk < 32) { const int lo = 256 * tb[blk] + ltot[blk], hi = 256 * tb[blk + 1]; for (int q = lo + c.tid; q < hi; q += NTHREADS) c.wsi(WS_SLOTTOK)[q] = 0; }
    }
}

struct CmpOrder {
    int G, c; const bf16* a0; const bf16* a1; const bf16* b0; const bf16* b1; size_t atile;
    DI bool next(int i, pg8::Unit& u) const { if (c < 0) return false; const int L = i * G + c; if (L >= 16) return false; u.kind = L >> 3; u.pm = L & 7; u.pn = 0; u.e = 0; return true; }
    DI const char* abase(const pg8::Gemm&, const pg8::Unit& u) const { return (const char*)(u.kind ? a1 : a0) + (size_t)u.pm * atile; }
    DI const char* bbase(const pg8::Gemm&, const pg8::Unit& u) const { return (const char*)(u.kind ? b1 : b0); }
    DI int arow(const pg8::Unit&, int r) const { return r; }
};
struct XqkvOrder {
    int G, c; const bf16* hn; const bf16* memn; const bf16* wq; const bf16* wkv;
    DI bool next(int i, pg8::Unit& u) const { const int L = i * G + c; if (L >= 144) return false;
        if (L < 128) { u.kind = 0; u.pm = L; u.pn = 0; } else { u.kind = 1; u.pm = (L - 128) >> 1; u.pn = (L - 128) & 1; } u.e = i & 15; return true; }
    DI const char* abase(const pg8::Gemm&, const pg8::Unit& u) const { return (const char*)(u.kind ? memn : hn) + (size_t)u.pm * 256 * DM * 2; }
    DI const char* bbase(const pg8::Gemm&, const pg8::Unit& u) const { return (const char*)(u.kind ? wkv : wq) + (size_t)u.pn * 256 * DM * 2; }
    DI int arow(const pg8::Unit&, int r) const { return r; }
};
struct MoeOrder {
    int G, c, npn, lognpn; const LAS int* tb; const LAS unsigned char* t2e; const int* slottok; const bf16* bw; size_t bexp, btile;
    DI bool next(int i, pg8::Unit& u) const { const int L = i * G + c; const int ntl = __builtin_amdgcn_readfirstlane(tb[32]); if (L >= ntl * npn) return false; u.pm = L >> lognpn; u.pn = L & (npn - 1); u.e = __builtin_amdgcn_readfirstlane((int)t2e[u.pm]); u.kind = 0; return true; }
    DI const char* abase(const pg8::Gemm& g, const pg8::Unit& u) const { return (const char*)g.A + (size_t)u.pm * 256 * g.lda * 2; }
    DI const char* bbase(const pg8::Gemm&, const pg8::Unit& u) const { return (const char*)bw + (size_t)u.e * bexp + (size_t)u.pn * btile; }
    DI int arow(const pg8::Unit& u, int r) const { return slottok[u.pm * 256 + r]; }
};

constexpr int NPH = 17;
template <unsigned MASK>
__global__ void __launch_bounds__(NTHREADS, 2) fwd(Args a) {
    extern __shared__ __attribute__((aligned(16))) unsigned char lds_raw[];
    Ctx c; c.in = (const float* const __attribute__((address_space(4)))*)__builtin_amdgcn_kernarg_segment_ptr(); c.out = a.out; c.ws = a.ws; c.lds = (LAS unsigned char*)lds_raw;
    c.tid = threadIdx.x; c.lane = c.tid & 63; c.wave = __builtin_amdgcn_readfirstlane(c.tid >> 6); c.G = gridDim.x; c.blk = blockIdx.x;
    c.gw = c.blk * NWAVES + c.wave; c.ngw = c.G * NWAVES; c.l = 0;
#define FRESH() do { int t_ = threadIdx.x; asm volatile("" : "+v"(t_)); c.tid = t_; c.lane = t_ & 63; c.wave = __builtin_amdgcn_readfirstlane(t_ >> 6); \
        { int b_ = blockIdx.x, g_ = gridDim.x; asm volatile("" : "+s"(b_), "+s"(g_)); c.blk = b_; c.G = g_; c.ngw = g_ * NWAVES; } c.gw = c.blk * NWAVES + c.wave; \
        size_t z_ = 0; asm volatile("" : "+s"(z_)); c.in = (const float* const __attribute__((address_space(4)))*)__builtin_amdgcn_kernarg_segment_ptr() + z_; c.ws = a.ws + z_; c.out = a.out + z_; c.lds = (LAS unsigned char*)lds_raw + (unsigned)z_; L = c.lds; } while (0)
    volatile LAS unsigned* bst = (volatile LAS unsigned*)(c.lds + LDS_MISC);
    if (c.tid < 4) bst[c.tid] = 0u;
    __syncthreads();
    XcdBarrier bar; bar.bar = (unsigned*)(a.ws + WS_CTL) + CW_BAR; bar.x = 0; bar.st = bst;
#if MK_SINGLE
    bar = xcd_barrier_post((unsigned*)(a.ws + WS_CTL) + CW_BAR, bst);
#define GRID_BAR() xcd_barrier(bar)
#else
#define GRID_BAR() do {} while (0)
#endif
    LAS unsigned char* L = c.lds;
    if (EN(0) && a.pro) { FRESH(); phase_prologue(c); if (!MK_SINGLE) GRID_BAR(); }
    const int lo = a.ph_lo, hi = a.ph_hi; (void)lo; (void)hi;
#if MK_SINGLE
#define IN(k) (EN(k))
#else
#define IN(k) (EN(k) && lo <= (k) && (k) < hi)
#endif
    for (int l = a.l_lo; l < a.l_hi; ++l) {
        c.l = l;
        if (IN(1)) for (int rr = 0; rr < REPN(1); ++rr) { FRESH(); phase_norm_mix(c, rr + 1 < REPN(1)); GRID_BAR(); }
        if (IN(2)) for (int rr = 0; rr < REPN(2); ++rr) { FRESH();
            pg8::Gemm g{c.wsb(WS_HN), c.wsb(WS_WIN + l * WIN_L), DM, DM, DM}; pg8::StaticOrder S; S.init(T, PC, c.G, c.blk);
            pg8::EpiBf16 E{c.wsb(WS_PROJ), PC};
            pg8::gemm_phase<pg8::EpiBf16, pg8::StaticOrder, false>(L, g, S, E); GRID_BAR(); }
        if (IN(4)) for (int rr = 0; rr < REPN(4); ++rr) { FRESH();
            if (rr == 0) phase_prep(c, false);
            FRESH();
            for (int r2_ = 0; r2_ < (REP_PH == 41 ? 2 : 1); ++r2_) { if (SUB(1) && c.blk < 2048) { u32x4 rv[4]; { int t0_ = c.tid; asm volatile("" : "+v"(t0_)); gdn_raw_load(c, c.blk, t0_, rv); }
                for (int it = c.blk; it < 2048; it += c.G) gdn_prep_item(c, it, it + c.G < 2048 ? it + c.G : -1, rv); } }
            FRESH();
            for (int r2_ = 0; r2_ < (REP_PH == 42 ? 2 : 1); ++r2_) { if (SUB(2)) for (int it = c.blk; it < 512; it += c.G) mlstm_prep_mf(c, it); }
            GRID_BAR(); }
        if (IN(5)) for (int rr = 0; rr < REPN(5); ++rr) { FRESH();
            const int cmp_c = (c.G >= 80) ? c.blk - 64 : c.blk;
            if (SUB(0)) { pg8::Gemm g{c.wsb(WS_KCR), c.wsb(WS_CW1), 1024, 2048, 2048};
              CmpOrder S{c.G, cmp_c, c.wsb(WS_KCR), c.wsb(WS_VCR), c.wsb(WS_CW1 + (size_t)(l * 2) * MiB), c.wsb(WS_CW1 + (size_t)(l * 2 + 1) * MiB), (size_t)256 * 1024 * 2};
              pg8::EpiCmp1 E{c.wsb(WS_HID)};
              pg8::gemm_phase<pg8::EpiCmp1, CmpOrder, false>(L, g, S, E);
              __syncthreads();
              if (cmp_c >= 0) for (int u = cmp_c; u < 16; u += c.G) phase_cmp_stage2(c, u * 256, u * 256 + 256, c.wave, NWAVES); }
            __syncthreads();
            const float lam_init = 0.8f - 0.6f * __expf(-0.3f * (float)l);
            float lam_full; { const float* lm = c.in[17] + (size_t)l * 128 + (c.lane & 31); const float s1 = wsum(c.lane < 32 ? lm[0] * lm[32] : 0.f), s2 = wsum(c.lane < 32 ? lm[64] * lm[96] : 0.f); lam_full = __expf(s1) - __expf(s2) + lam_init; }
            FRESH();
            if (SUB(1)) for (int grep_ = 0; grep_ < (EXPT == 11 ? 2 : 1); ++grep_) for (int it = c.blk; it < 32; it += c.G) gdn_scan_item(c, it, c.in[12] + (size_t)l * 64);
            FRESH();
            if (SUB(2)) for (int mrep_ = 0; mrep_ < (EXPT == 12 ? 2 : 1); ++mrep_) for (int it = c.blk; it < 64; it += c.G) if (it >= 32) mlstm_scan_item(c, it - 32);
            FRESH();
            if (SUB(3)) for (int qrep = 0; qrep < (EXPT == 10 ? 2 : 1); ++qrep) { unsigned* qctr = (unsigned*)(c.ws + WS_CTL) + 512 + 64 * (2 * l + rr) + 32 * qrep; volatile LAS unsigned* qs = (volatile LAS unsigned*)(c.lds + LDS_MISC + 32);
                for (;;) {
                    __syncthreads();
                    if (c.tid == 0) qs[0] = __hip_atomic_fetch_add(qctr, 1u, __ATOMIC_RELAXED, __HIP_MEMORY_SCOPE_AGENT);
                    __syncthreads();
                    const int k = __builtin_amdgcn_readfirstlane((int)qs[0]);
                    if (k >= 1024) break;
                    const int qt = 31 - (k >> 5), bh = k & 31;
                    diff_item(c, bh >> 2, bh & 3, qt, lam_full, lam_init);
                } }
            GRID_BAR(); }
        if (IN(7)) for (int rr = 0; rr < REPN(7); ++rr) { FRESH();
            for (int mo_ = 0; mo_ < (EXPT == 21 ? 2 : 1); ++mo_) for (int it = c.blk; it < 512; it += c.G) mlstm_out_mf(c, it);
            FRESH();
            if (SUB(3)) for (int nr_ = 0; nr_ < (EXPT == 20 ? 2 : 1); ++nr_) for (int p = c.blk; p < 256; p += c.G) { const int b = p >> 5, q = p & 31;
#pragma unroll 1
                for (int rep = 0; rep < 2; ++rep) nsa_item(c, b, rep ? q : 63 - q); }
            GRID_BAR(); }
        if (IN(8)) for (int rr = 0; rr < REPN(8); ++rr) { FRESH();
            pg8::Gemm g{c.wsb(WS_HN), c.wsb(WS_WOUT + (size_t)l * 2 * MiB), DM, DM, DM}; pg8::StaticOrder S; S.init(T, DM, c.G, c.blk);
            pg8::EpiResid E{(l == 0) ? c.in[0] : (const float*)nullptr, c.wsb(WS_RES), c.wsb(WS_RES), (rr + 1 < REPN(8)) ? 0.f : 1.f};
            pg8::gemm_phase<pg8::EpiResid, pg8::StaticOrder, false>(L, g, S, E); GRID_BAR(); }
        if (IN(10)) for (int rr = 0; rr < REPN(10); ++rr) { FRESH();
            LAS float* rstab = (LAS float*)(c.lds + LDS_GOFF);
            if (c.blk == 0 && c.tid < 128) c.wsi(WS_MCNT)[c.tid] = 0;
            { int li = 0; for (int u0 = c.blk; u0 < 128; u0 += c.G, ++li) {
                for (int r = c.wave; r < 256; r += NWAVES) { f32x4 v[4]; row_load_bf(c.wsb(WS_RES) + (size_t)(u0 * 256 + r) * DM, c.lane, v);
                    const float rs = rsq(row_ss(v) * (1.f / DM) + EPS); if (c.lane == 0) rstab[(li & 15) * 256 + r] = rs; } } }
            __syncthreads();
            pg8::Gemm g{c.wsb(WS_RES), c.wsb(WS_XWQ), DM, DM, DM};
            XqkvOrder S{c.G, c.blk, c.wsb(WS_RES), c.wsb(WS_MEMN + (size_t)l * 4 * MiB), c.wsb(WS_XWQ + (size_t)l * 512 * KiB), c.wsb(WS_XWKV + (size_t)l * MiB)};
            pg8::EpiXqkv E{c.wsb(WS_XQ), c.wsb(WS_XKV), rstab};
            pg8::gemm_phase<pg8::EpiXqkv, XqkvOrder, false>(L, g, S, E);
            if (c.G > 144) { if (c.blk >= 144) convert_moe_weights(c, (c.blk - 144) * NWAVES + c.wave, (c.G - 144) * NWAVES); }
            else convert_moe_weights(c, c.gw, c.ngw);
            GRID_BAR(); }
        if (IN(11)) for (int rr = 0; rr < REPN(11); ++rr) { FRESH(); for (int it = c.blk; it < 512; it += c.G) { const int b = it >> 6, h = (it >> 4) & 3, q = it & 15; xattn_item(c, b, h, q); } GRID_BAR(); }
        if (IN(12)) for (int rr = 0; rr < REPN(12); ++rr) { FRESH();
            pg8::Gemm g{c.wsb(WS_XAO), c.wsb(WS_XWO + (size_t)l * 512 * KiB), 256, 256, 256}; pg8::StaticOrder S; S.init(T, DM, c.G, c.blk);
            pg8::EpiResid E{(const float*)nullptr, c.wsb(WS_RES), c.wsb(WS_RES), (rr + 1 < REPN(12)) ? 0.f : 1.f};
            pg8::gemm_phase<pg8::EpiResid, pg8::StaticOrder, false>(L, g, S, E); GRID_BAR(); }
        if (IN(13)) for (int rr = 0; rr < REPN(13); ++rr) { FRESH(); phase_norm_route(c, rr + 1 < REPN(13)); GRID_BAR(); }
        if (IN(14)) for (int rr = 0; rr < REPN(14); ++rr) { FRESH(); phase_moe_slots(c, rr + 1 < REPN(14)); GRID_BAR(); }
        if (IN(15)) for (int rr = 0; rr < REPN(15); ++rr) { FRESH();
            LAS int* tb = (LAS int*)(c.lds + LDS_MISC + 64); LAS unsigned char* t2e = (LAS unsigned char*)(c.lds + LDS_MISC + 256);
            moe_tiles(c, tb, t2e);
            pg8::Gemm g{c.wsb(WS_RES), c.wsb(WS_MW13), DM, DM, DM};
            MoeOrder S{c.G, c.blk, 2, 1, tb, t2e, c.wsi(WS_SLOTTOK), c.wsb(WS_MW13), (size_t)MiB, (size_t)256 * DM * 2};
            pg8::EpiSwiglu E{c.wsb(WS_ACT), c.wsi(WS_SLOTTOK), c.wsf(WS_RS)};
            pg8::gemm_phase<pg8::EpiSwiglu, MoeOrder, true>(L, g, S, E); GRID_BAR(); }
        if (IN(16)) for (int rr = 0; rr < REPN(16); ++rr) { FRESH();
            LAS int* tb = (LAS int*)(c.lds + LDS_MISC + 64); LAS unsigned char* t2e = (LAS unsigned char*)(c.lds + LDS_MISC + 256);
            moe_tiles(c, tb, t2e);
            pg8::Gemm g{c.wsb(WS_ACT), c.wsb(WS_MW2), 256, 256, 256};
            MoeOrder S{c.G, c.blk, 4, 2, tb, t2e, c.wsi(WS_SLOTTOK), c.wsb(WS_MW2), (size_t)512 * KiB, (size_t)256 * 256 * 2};
            pg8::EpiBf16 E{c.wsb(WS_YMOE), DM};
            pg8::gemm_phase<pg8::EpiBf16, MoeOrder, false>(L, g, S, E); GRID_BAR(); }
    }
    if (EN(17) && a.fin) { FRESH(); phase_final(c); }
#undef IN
}

typedef void (*KernFn)(Args);
template <unsigned MASK> static bool prep_kernel() {
    return hipFuncSetAttribute((const void*)fwd<MASK>, hipFuncAttributeMaxDynamicSharedMemorySize, LDS_BYTES) == hipSuccess;
}
#if !MK_SINGLE
template <int P> static void launch_phase(int grid, hipStream_t stream, const Args& a) { hipLaunchKernelGGL(fwd<(1u << P)>, dim3(grid), dim3(NTHREADS), LDS_BYTES, stream, a); }
static void launch_phase_rt(int p, int grid, hipStream_t stream, const Args& a) {
    switch (p) {
        case 0: launch_phase<0>(grid, stream, a); break;   case 1: launch_phase<1>(grid, stream, a); break;   case 2: launch_phase<2>(grid, stream, a); break;
        case 3: launch_phase<3>(grid, stream, a); break;   case 4: launch_phase<4>(grid, stream, a); break;   case 5: launch_phase<5>(grid, stream, a); break;
        case 6: launch_phase<6>(grid, stream, a); break;   case 7: launch_phase<7>(grid, stream, a); break;   case 8: launch_phase<8>(grid, stream, a); break;
        case 9: launch_phase<9>(grid, stream, a); break;   case 10: launch_phase<10>(grid, stream, a); break; case 11: launch_phase<11>(grid, stream, a); break;
        case 12: launch_phase<12>(grid, stream, a); break; case 13: launch_phase<13>(grid, stream, a); break; case 14: launch_phase<14>(grid, stream, a); break;
        case 15: launch_phase<15>(grid, stream, a); break; case 16: launch_phase<16>(grid, stream, a); break; case 17: launch_phase<17>(grid, stream, a); break;
        default: break;
    }
}
template <int P> static bool prep_all() { if (!prep_kernel<(1u << P)>()) return false; if constexpr (P > 0) return prep_all<P - 1>(); else return true; }
#endif
extern "C" void kernel_launch(void* const* d_in, const int* in_sizes, int n_in, void* d_out, int out_size, void* d_ws, size_t ws_size, hipStream_t stream) {
    static int grid = 0;
    if (grid == 0) {
        if (n_in != 33 || out_size != T * DM || ws_size < WS_END) { fprintf(stderr, "kernel_launch: unexpected problem (n_in %d, out %d, ws %zu)\n", n_in, out_size, ws_size); grid = -1; return; }
        int dev = 0, cus = 0, per_cu = 0;
        if (hipGetDevice(&dev) != hipSuccess || hipDeviceGetAttribute(&cus, hipDeviceAttributeMultiprocessorCount, dev) != hipSuccess) { grid = -1; return; }
#if MK_SINGLE
        if (!prep_kernel<0xFFFFFFFFu>()) { fprintf(stderr, "kernel_launch: hipFuncSetAttribute failed\n"); grid = -1; return; }
        if (hipOccupancyMaxActiveBlocksPerMultiprocessor(&per_cu, (const void*)fwd<0xFFFFFFFFu>, NTHREADS, LDS_BYTES) != hipSuccess || per_cu < 1) fprintf(stderr, "kernel_launch: occupancy query reports %d\n", per_cu);
#else
        if (!prep_all<17>()) { fprintf(stderr, "kernel_launch: hipFuncSetAttribute failed\n"); grid = -1; return; }
        (void)per_cu;
#endif
        (void)hipGetLastError();
        grid = cus;
    }
    if (grid < 0) return;
    (void)hipMemsetAsync((char*)d_ws + WS_CTL, 0, CTL_ZERO_BYTES, stream);
    Args a{};
    for (int i = 0; i < 33; ++i) a.in[i] = (const float*)d_in[i];
    a.out = (float*)d_out; a.ws = (unsigned char*)d_ws;
#if MK_SINGLE
    a.l_lo = 0; a.l_hi = 2; a.ph_lo = 1; a.ph_hi = NPH; a.pro = 1; a.fin = 1;
    hipLaunchKernelGGL(fwd<0xFFFFFFFFu>, dim3(grid), dim3(NTHREADS), LDS_BYTES, stream, a);
#else
    a.l_lo = 0; a.l_hi = 0; a.ph_lo = 0; a.ph_hi = 0; a.pro = 1; a.fin = 0;
    launch_phase_rt(0, grid, stream, a);
    a.pro = 0;
    for (int l = 0; l < 2; ++l) for (int p = 1; p < NPH; ++p) { a.l_lo = l; a.l_hi = l + 1; a.ph_lo = p; a.ph_hi = p + 1; launch_phase_rt(p, grid, stream, a); }
    a.l_lo = 0; a.l_hi = 0; a.ph_lo = 0; a.ph_hi = 0; a.fin = 1;
    launch_phase_rt(17, grid, stream, a);
#endif
}
```

```cpp
#include <hip/hip_runtime.h>
#include <stdint.h>
#include <stdio.h>

#ifndef MK_SINGLE
#define MK_SINGLE 1
#endif

#define DI __device__ __forceinline__
#ifndef PH_MASK
#define PH_MASK 0xFFFFFFFFu
#endif
#define EN(k) ((MASK >> (k)) & 1u)
#ifndef REP_PH
#define REP_PH -1
#endif
#ifndef EXPT
#define EXPT 0
#endif
#ifndef REP_L
#define REP_L -1
#endif
#define REPN(k) (((k) == REP_PH && (REP_L < 0 || l == REP_L)) ? 2 : 1)
#ifndef SUB_MASK
#define SUB_MASK 0xFu
#endif
#define SUB(k) (((SUB_MASK >> (k)) & 1u) || rr > 0 || REP_PH < 0)
#define LAS __attribute__((address_space(3)))
typedef unsigned short bf16;
typedef short bf16x8 __attribute__((ext_vector_type(8)));
typedef short s16x4 __attribute__((ext_vector_type(4)));
typedef float f32x2 __attribute__((ext_vector_type(2)));
typedef float f32x4 __attribute__((ext_vector_type(4)));
typedef float f32x16 __attribute__((ext_vector_type(16)));
typedef unsigned u32x2 __attribute__((ext_vector_type(2)));
typedef unsigned u32x4 __attribute__((ext_vector_type(4)));
typedef __bf16 hbf2 __attribute__((ext_vector_type(2)));

constexpr int NB = 8, SEQ = 4096, T = NB * SEQ, DM = 1024, PC = 3328;
constexpr int A_Q = 0, A_KC = 256, A_VC = 320, A_KS = 384, A_VS = 448, A_KW = 512, A_VW = 576;
constexpr int B_Q = 640, B_K = 896, B_V = 1152, B_Z = 1408;
constexpr int C_Q = 1664, C_K = 1792, C_V = 1920, C_O = 2176;
constexpr int D_Q = 2432, D_K = 2688, D_V = 2944, SMC = 3200;
constexpr float EPS = 1e-6f;
constexpr float LOG2E = 1.4426950408889634f;
constexpr float QSCALE = 0.125f * LOG2E;
constexpr float DSCALE = 0.17677669529663687f * LOG2E;
constexpr int NTHREADS = 512, NWAVES = 8;
constexpr int NSLOT = 73728;

constexpr size_t MiB = 1u << 20, KiB = 1u << 10;
constexpr size_t WS_CTL = 0, CTL_ZERO_BYTES = 64 * KiB;
constexpr size_t WS_WIN = 1 * MiB;
constexpr size_t WIN_L = (size_t)PC * DM * 2;
constexpr size_t WS_WOUT = 14 * MiB;
constexpr size_t WS_CW1 = 18 * MiB;
constexpr size_t WS_CW2 = 22 * MiB;
constexpr size_t WS_CB1 = 22 * MiB + 256 * KiB;
constexpr size_t WS_ROPE = 22 * MiB + 512 * KiB;
constexpr size_t WS_XWQ = 24 * MiB;
constexpr size_t WS_XWKV = 25 * MiB;
constexpr size_t WS_XWO = 27 * MiB;
constexpr size_t WS_WRT = 28 * MiB;
constexpr size_t WS_MEMN = 446 * MiB;
constexpr size_t WS_MW13 = 33 * MiB;
constexpr size_t WS_MW2 = 65 * MiB;
constexpr size_t WS_HN = 81 * MiB;
constexpr size_t WS_PROJ = 145 * MiB;
constexpr size_t WS_KCR = 353 * MiB;
constexpr size_t WS_VCR = 357 * MiB + 512 * KiB;
constexpr size_t WS_HID = 362 * MiB;
constexpr size_t WS_KCL = 364 * MiB;
constexpr size_t WS_VCL = 364 * MiB + 512 * KiB;
constexpr size_t WS_RES = 365 * MiB;
constexpr size_t OUT_GW = 0;
constexpr size_t WS_GL = 445 * MiB;
constexpr size_t OUT_CLOC = 80 * MiB;
constexpr size_t OUT_CIN = 96 * MiB;
constexpr size_t WS_NLOC = 478 * MiB;
constexpr size_t WS_NIN = 478 * MiB + 256 * KiB;
constexpr size_t WS_MLOC = 478 * MiB + 512 * KiB;
constexpr size_t WS_BLAST = WS_MLOC + 8 * KiB;
constexpr size_t WS_MIN = WS_MLOC + 16 * KiB;
constexpr size_t WS_TOKE = 479 * MiB;
constexpr size_t WS_TOKW = WS_TOKE + 256 * KiB;
constexpr size_t WS_TOKS = WS_TOKW + 256 * KiB;
constexpr size_t WS_SLOTTOK = WS_TOKS + 256 * KiB;
constexpr size_t WS_MCNT = WS_SLOTTOK + 320 * KiB;
constexpr size_t WS_BLKCNT = WS_MCNT + 1 * KiB;
constexpr size_t WS_KCN = 480 * MiB + 256 * KiB;
constexpr size_t WS_VCN = 480 * MiB + 512 * KiB;
constexpr size_t WS_RS = 480 * MiB + 768 * KiB;
constexpr size_t WS_END = 481 * MiB;
constexpr size_t WS_XQ = WS_PROJ;
constexpr size_t WS_XAO = WS_PROJ + 16 * MiB;
constexpr size_t WS_XKV = WS_PROJ + 32 * MiB;
constexpr size_t WS_ACT = WS_PROJ;
constexpr size_t WS_YMOE = WS_PROJ + 40 * MiB;
constexpr int CW_BAR = 1024;

constexpr int LDS_BYTES = 163840;
constexpr int LDS_MISC = 131072;
constexpr int LDS_GOFF = 131072 + 2048;

DI unsigned pk2(float lo, float hi) { f32x2 v = {lo, hi}; hbf2 b = __builtin_convertvector(v, hbf2); return __builtin_bit_cast(unsigned, b); }
DI bf16 f2bf(float f) { return (bf16)(pk2(f, 0.f) & 0xffffu); }
DI u32x4 f8_to_bf(const float (&x)[8]) { u32x4 r; r.x = pk2(x[0], x[1]); r.y = pk2(x[2], x[3]); r.z = pk2(x[4], x[5]); r.w = pk2(x[6], x[7]); return r; }
DI float bf2f(bf16 b) { return __builtin_bit_cast(float, ((unsigned)b) << 16); }
DI float bflo(unsigned u) { return __builtin_bit_cast(float, u << 16); }
DI float bfhi(unsigned u) { return __builtin_bit_cast(float, u & 0xffff0000u); }
DI float ex2(float x) { return __builtin_amdgcn_exp2f(x); }
DI float fexp(float x) { return __builtin_amdgcn_exp2f(x * LOG2E); }
DI float flog(float x) { return __builtin_amdgcn_logf(x) * 0.6931471805599453f; }
DI float sigm(float x) { return 1.f / (1.f + fexp(-x)); }
DI float silu(float x) { return x / (1.f + fexp(-x)); }
DI float tanh_(float x) { const float e = fexp(2.f * x); return 1.f - 2.f / (e + 1.f); }
DI float softplus_(float x) { return fmaxf(x, 0.f) + flog(1.f + fexp(-fabsf(x))); }
DI float gelu_tanh(float x) { const float u = 0.7978845608028654f * (x + 0.044715f * x * x * x); return 0.5f * x * (1.f + tanh_(u)); }
DI float rsq(float x) { return 1.f / sqrtf(x); }
DI int lane_op() { int l = (int)__lane_id(); asm volatile("" : "+v"(l)); return l; }
DI int shx(int v, int m) {
    if (__builtin_constant_p(m) && m == 1) return __builtin_amdgcn_mov_dpp(v, 0xB1, 0xF, 0xF, true);
    if (__builtin_constant_p(m) && m == 2) return __builtin_amdgcn_mov_dpp(v, 0x4E, 0xF, 0xF, true);
    if (__builtin_constant_p(m) && m == 4) return __builtin_amdgcn_ds_swizzle(v, 0x101F);
    if (__builtin_constant_p(m) && m == 8) return __builtin_amdgcn_ds_swizzle(v, 0x201F);
    if (__builtin_constant_p(m) && m == 16) return __builtin_amdgcn_ds_swizzle(v, 0x401F);
    return __builtin_amdgcn_ds_bpermute((lane_op() ^ m) << 2, v); }
DI float shx(float v, int m) { return __builtin_bit_cast(float, shx(__builtin_bit_cast(int, v), m)); }
DI int shu(int v, int o) { const int l = lane_op(); return __builtin_amdgcn_ds_bpermute((l >= o ? l - o : l) << 2, v); }
DI float shu(float v, int o) { return __builtin_bit_cast(float, shu(__builtin_bit_cast(int, v), o)); }
DI float wsum(float v) {
#pragma unroll
    for (int o = 1; o < 64; o <<= 1) v += shx(v, o);
    return v;
}
DI float wmax(float v) {
#pragma unroll
    for (int o = 1; o < 64; o <<= 1) v = fmaxf(v, shx(v, o));
    return v;
}
DI int crow(int r, int hi) { return (r & 3) + 8 * (r >> 2) + 4 * hi; }
#define CR(r) (((r) & 3) + 8 * ((r) >> 2))
#define MFMA32(a, b, c) __builtin_amdgcn_mfma_f32_32x32x16_bf16((a), (b), (c), 0, 0, 0)
#define LDS_WAIT() asm volatile("s_waitcnt lgkmcnt(0)" ::: "memory")

#define XB_TMO      128
#define XB_XCNT(j)  (256  + 64 * (j))
#define XB_XSUB(j)  (1280 + 64 * (j))
#define XB_XGEN(j)  (2304 + 64 * (j))
#define XB_TOP      3328
#define XB_TOPGEN   3392
#define XCD_BAR_WORDS 3456
#define XB_SPIN_CAP (1u << 21)

DI unsigned xb_ld(unsigned* p)              { return __hip_atomic_load(p, __ATOMIC_RELAXED, __HIP_MEMORY_SCOPE_AGENT); }
DI unsigned xb_add(unsigned* p, unsigned v) { return __hip_atomic_fetch_add(p, v, __ATOMIC_RELAXED, __HIP_MEMORY_SCOPE_AGENT); }
DI unsigned xb_xcc_id() { return (unsigned)__builtin_amdgcn_s_getreg((3 << 11) | 20) & 0xFu; }
#define XB_SPIN(cond, bar) do { unsigned _sp = 0; while (cond) { __builtin_amdgcn_s_sleep(1); \
    if ((++_sp & 255u) == 0u) { if (xb_ld(&(bar)[XB_TMO])) break; if (_sp > XB_SPIN_CAP) { atomicAdd(&(bar)[XB_TMO], 1u); break; } } } } while (0)

struct XcdBarrier { unsigned* bar; unsigned x; volatile LAS unsigned* st; };

DI XcdBarrier xcd_barrier_post(unsigned* bar, volatile LAS unsigned* st) {
    XcdBarrier b; b.bar = bar; b.x = xb_xcc_id(); b.st = st;
    if (threadIdx.x == 0) (void)xb_add(&bar[XB_XCNT(b.x)], 1u);
    return b;
}
DI void xcd_barrier_complete(unsigned* bar, unsigned x, unsigned& nloc, unsigned& nx) {
    const unsigned G = gridDim.x * gridDim.y * gridDim.z;
    unsigned sum, cnt, mine, sp = 0u;
    for (;;) {
        sum = 0u; cnt = 0u; mine = 0u;
#pragma unroll
        for (unsigned j = 0; j < 16; ++j) { const unsigned c = xb_ld(&bar[XB_XCNT(j)]); sum += c; cnt += (c > 0u) ? 1u : 0u; }
        if (sum == G) break;
        __builtin_amdgcn_s_sleep(1);
        if ((++sp & 255u) == 0u) { if (xb_ld(&bar[XB_TMO])) break; if (sp > XB_SPIN_CAP) { atomicAdd(&bar[XB_TMO], 1u); break; } }
    }
    mine = xb_ld(&bar[XB_XCNT(x)]);
    nloc = mine > 0u ? mine : 1u; nx = cnt > 0u ? cnt : 1u;
}
DI void xcd_barrier(const XcdBarrier& b) {
    asm volatile("s_waitcnt vmcnt(0)" ::: "memory");
    __syncthreads();
    if (threadIdx.x == 0) {
        unsigned* bar = b.bar;
        __builtin_amdgcn_s_waitcnt(0);
        unsigned nloc = b.st[0], nx = b.st[1];
        if (nloc == 0u) { xcd_barrier_complete(bar, b.x, nloc, nx); b.st[0] = nloc; b.st[1] = nx; }
        const unsigned old = xb_add(&bar[XB_XSUB(b.x)], 1u);
        const unsigned gen = old / nloc;
        if (old + 1u == (gen + 1u) * nloc) {
            __builtin_amdgcn_fence(__ATOMIC_RELEASE, "agent");
            asm volatile("s_waitcnt vmcnt(0)" ::: "memory");
            const unsigned og = xb_add(&bar[XB_TOP], 1u);
            const unsigned tg = og / nx;
            if (og + 1u == (tg + 1u) * nx) xb_add(&bar[XB_TOPGEN], 1u);
            else XB_SPIN(xb_ld(&bar[XB_TOPGEN]) == tg, bar);
            __builtin_amdgcn_fence(__ATOMIC_ACQUIRE, "agent");
            xb_add(&bar[XB_XGEN(b.x)], 1u);
            asm volatile("s_waitcnt vmcnt(0)" ::: "memory");
        } else {
            XB_SPIN(xb_ld(&bar[XB_XGEN(b.x)]) == gen, bar);
            __builtin_amdgcn_fence(__ATOMIC_ACQUIRE, "agent");
            asm volatile("s_waitcnt vmcnt(0)" ::: "memory");
        }
    }
    __syncthreads();
}

namespace pg8 {
typedef float f32x4 __attribute__((ext_vector_type(4)));
constexpr int BM = 256, BK = 64, HALF = 128, HTB = HALF * BK * 2, NXCD = 8, WGM = 4;
DI int lds_byte(int r, int c) { const int st = (r >> 4) * 2 + (c >> 5), rr = r & 15, cc = c & 31, ob = rr * 64 + cc * 2; return st * 1024 + (ob ^ (((ob >> 9) & 1) << 5)); }
DI void stage_rc(int b, int& R, int& C) { const int st = b / 1024, sb = b % 1024, swz = sb ^ (((sb >> 9) & 1) << 5); R = (st >> 1) * 16 + swz / 64; C = (st & 1) * 32 + (swz % 64) / 2; }
DI int perm32(int rho) { const int n = rho >> 4, i = rho & 15; return 8 * (i >> 2) + 4 * n + (i & 3); }

struct Unit { int pm, pn, kind, e, half, rofs; };
struct Gemm { const bf16* A; const bf16* Bt; int lda, ldb, K; };

struct StaticOrder {
    int nM, nN, nwg, G, c;
    DI void init(int M, int N, int G_, int c_) { nM = M / BM; nN = N / BM; nwg = nM * nN; G = G_; c = c_; }
    DI bool next(int i, Unit& u) const {
        const long L = (long)i * G + c; const int nFull = (nwg / G) * G, R = nwg - nFull; int wgid; u.half = 0; u.rofs = 0;
        if (R > 0 && 2 * R <= G && L >= nFull) { const long h = L - nFull; if (h >= 2 * R) return false; wgid = nFull + (int)(h >> 1); u.half = 1; u.rofs = HALF * (int)(h & 1); }
        else { if (L >= nwg) return false; wgid = (int)L; }
        { const int q = nwg / NXCD, r = nwg % NXCD, xcd = wgid % NXCD, off = wgid / NXCD; wgid = (xcd < r ? xcd * (q + 1) : r * (q + 1) + (xcd - r) * q) + off; }
        const int nig = WGM * nN, gid = wgid / nig, fm = gid * WGM, gsz = (nM - fm) < WGM ? (nM - fm) : WGM;
        u.pm = fm + ((wgid % nig) % gsz); u.pn = (wgid % nig) / gsz; u.kind = 0; u.e = 0; return true;
    }
    DI const char* abase(const Gemm& g, const Unit& u) const { return (const char*)g.A + (size_t)(u.pm * BM + u.rofs) * g.lda * 2; }
    DI const char* bbase(const Gemm& g, const Unit& u) const { return (const char*)g.Bt + (size_t)u.pn * BM * g.ldb * 2; }
    DI int arow(const Unit&, int r) const { return r; }
};

template <class Epi, class Sched, bool GATHER>
DI void gemm_phase(LAS unsigned char* lds, const Gemm g, const Sched& S, const Epi& E) {
    int tid = threadIdx.x; asm volatile("" : "+v"(tid));
    const int wid = __builtin_amdgcn_readfirstlane(tid >> 6), lane = tid & 63, wr = wid >> 2, wc = wid & 3, fr = lane & 15, fq = lane >> 4;
    const int K = g.K, nt = K / BK;
    unsigned voffA[2], voffB[2];
#pragma unroll
    for (int i = 0; i < 2; ++i) { int R, C; stage_rc(tid * 16 + i * 8192, R, C); const int Rb = (R & ~31) + perm32(R & 31);
        voffA[i] = (unsigned)(R * g.lda + C) * 2u; voffB[i] = (unsigned)(Rb * g.ldb + C) * 2u; }
    const size_t kstep = (size_t)(BK * 2);
    const size_t hstepA = (size_t)HALF * g.lda * 2, hstepB = (size_t)HALF * g.ldb * 2;
    const unsigned ldsw = (unsigned)wid * 1024u;
    const int aoff = lds_byte(wr * 64 + fr, fq * 8), boff = lds_byte(wc * 32 + fr, fq * 8);
#define PG8_SA(b, h) (((b) * 2 + (h)) * HTB)
#define PG8_SB(b, h) ((4 + (b) * 2 + (h)) * HTB)
#define PG8_GLDS(bufoff, p0, p1) do { \
        __builtin_amdgcn_global_load_lds((const unsigned*)(p0), (LAS unsigned*)(lds + (bufoff) + ldsw), 16, 0, 0); \
        __builtin_amdgcn_global_load_lds((const unsigned*)(p1), (LAS unsigned*)(lds + (bufoff) + ldsw + 8192), 16, 0, 0); } while (0)
#define PG8_STAGEB(bufoff, gbase) PG8_GLDS(bufoff, (const char*)(gbase) + voffB[0], (const char*)(gbase) + voffB[1])
#define PG8_STAGEA(bufoff, nx, h, koff) do { if constexpr (GATHER) { \
            const int _par = ((nx) ? ui + 1 : ui) & 1; const unsigned _v0 = goff[(_par * 4 + (h) * 2) * 512], _v1 = goff[(_par * 4 + (h) * 2 + 1) * 512]; \
            PG8_GLDS(bufoff, (const char*)g.A + (koff) + _v0, (const char*)g.A + (koff) + _v1); \
        } else { const char* _b = ((nx) ? nA : cA) + (size_t)(h) * ((nx) ? nHs : cHs) + (koff); PG8_GLDS(bufoff, _b + voffA[0], _b + voffA[1]); } } while (0)
#define PG8_LDA(dst, b, h) do { _Pragma("unroll") for (int m = 0; m < 4; ++m) _Pragma("unroll") for (int k = 0; k < 2; ++k) dst[m][k] = *(const LAS bf16x8*)(lds + PG8_SA(b, h) + aoff + m * 2048 + k * 1024); } while (0)
#define PG8_LDB(dst, b, h) do { _Pragma("unroll") for (int n = 0; n < 2; ++n) _Pragma("unroll") for (int k = 0; k < 2; ++k) dst[n][k] = *(const LAS bf16x8*)(lds + PG8_SB(b, h) + boff + n * 2048 + k * 1024); } while (0)
#define PG8_MMA(ai, bj, At, Bt) do { __builtin_amdgcn_s_setprio(1); _Pragma("unroll") for (int m = 0; m < 4; ++m) _Pragma("unroll") for (int n = 0; n < 2; ++n) _Pragma("unroll") for (int k = 0; k < 2; ++k) \
        acc[ai][bj][m][n] = __builtin_amdgcn_mfma_f32_16x16x32_bf16(Bt[n][k], At[m][k], acc[ai][bj][m][n], 0, 0, 0); __builtin_amdgcn_s_setprio(0); } while (0)
#define PG8_WAIT_V(n) asm volatile("s_waitcnt vmcnt(" #n ")" ::: "memory")
#define PG8_WAIT_L(n) asm volatile("s_waitcnt lgkmcnt(" #n ")" ::: "memory")
#define PG8_BAR __builtin_amdgcn_s_barrier()
#define PG8_SCHED __builtin_amdgcn_sched_barrier(0)
    Unit cur, nxt; int ui = 0;
    if (!S.next(0, cur)) return;
    f32x4 acc[2][2][4][2];
#pragma unroll
    for (int a = 0; a < 2; ++a)
#pragma unroll
        for (int b = 0; b < 2; ++b)
#pragma unroll
            for (int m = 0; m < 4; ++m)
#pragma unroll
                for (int n = 0; n < 2; ++n) acc[a][b][m][n] = (f32x4){0.f, 0.f, 0.f, 0.f};
    bf16x8 At[4][2], B0[2][2], B1[2][2];
    const char* cA = S.abase(g, cur); const char* cB = S.bbase(g, cur);
    const char* nA = cA; size_t cHs = cur.half ? (size_t)0 : hstepA, nHs = cHs;
    LAS unsigned* goff = (LAS unsigned*)(lds + LDS_GOFF) + tid;
#define PG8_GFILL(par, uu) do { _Pragma("unroll") for (int h = 0; h < 2; ++h) _Pragma("unroll") for (int i = 0; i < 2; ++i) { int R, C; stage_rc(tid * 16 + i * 8192, R, C); \
        goff[((par) * 4 + h * 2 + i) * 512] = (unsigned)S.arow(uu, ((uu).half ? 0 : h * HALF) + R) * (unsigned)(g.lda * 2) + (unsigned)(C * 2); } } while (0)
    if constexpr (GATHER) { PG8_GFILL(0, cur); }
    PG8_STAGEB(PG8_SB(0, 0), cB); PG8_STAGEB(PG8_SB(0, 1), cB + hstepB); PG8_STAGEA(PG8_SA(0, 0), false, 0, (size_t)0); PG8_STAGEA(PG8_SA(0, 1), false, 1, (size_t)0);
    if (wr == 1) PG8_BAR;
    PG8_WAIT_V(2); PG8_BAR;
    PG8_STAGEB(PG8_SB(1, 0), cB + kstep); PG8_STAGEA(PG8_SA(1, 0), false, 0, kstep); PG8_STAGEB(PG8_SB(1, 1), cB + hstepB + kstep);
    PG8_WAIT_V(6); PG8_BAR;
    for (;;) {
        const bool has_next = S.next(ui + 1, nxt);
        nA = has_next ? S.abase(g, nxt) : cA; const char* nB = has_next ? S.bbase(g, nxt) : cB; nHs = has_next ? (nxt.half ? (size_t)0 : hstepA) : cHs;
        if constexpr (GATHER) { if (has_next) PG8_GFILL((ui + 1) & 1, nxt); else PG8_GFILL((ui + 1) & 1, cur); }
#pragma unroll 1
        for (int t = 0; t < nt; t += 2) {
            const bool last = (t == nt - 2);
            const size_t k1 = (size_t)(t + 1) * kstep;
            const size_t k2 = last ? (size_t)0 : (size_t)(t + 2) * kstep, k3 = k2 + kstep;
            const char* b2 = last ? nB : cB + (size_t)(t + 2) * kstep; const char* b3 = b2 + kstep;
            PG8_LDB(B0, 0, 0); PG8_LDB(B1, 0, 1); PG8_SCHED; PG8_LDA(At, 0, 0); PG8_STAGEA(PG8_SA(1, 1), false, 1, k1);
            PG8_WAIT_V(8); PG8_WAIT_L(0); PG8_BAR; PG8_MMA(0, 0, At, B0); PG8_MMA(0, 1, At, B1); PG8_BAR; PG8_SCHED;
            PG8_LDA(At, 0, 1); PG8_STAGEB(PG8_SB(0, 0), b2); PG8_STAGEB(PG8_SB(0, 1), b2 + hstepB); PG8_STAGEA(PG8_SA(0, 0), last, 0, k2);
            PG8_WAIT_V(8); PG8_WAIT_L(0); PG8_BAR; if (!cur.half) { PG8_MMA(1, 0, At, B0); PG8_MMA(1, 1, At, B1); } PG8_BAR; PG8_SCHED;
            PG8_LDB(B0, 1, 0); PG8_LDB(B1, 1, 1); PG8_SCHED; PG8_LDA(At, 1, 0); PG8_STAGEA(PG8_SA(0, 1), last, 1, k2);
            PG8_WAIT_V(8); PG8_WAIT_L(0); PG8_BAR; PG8_MMA(0, 0, At, B0); PG8_MMA(0, 1, At, B1); PG8_BAR; PG8_SCHED;
            PG8_LDA(At, 1, 1); PG8_STAGEB(PG8_SB(1, 0), b3); PG8_STAGEB(PG8_SB(1, 1), b3 + hstepB); PG8_STAGEA(PG8_SA(1, 0), last, 0, k3);
            PG8_WAIT_V(8); PG8_WAIT_L(0); PG8_BAR; if (!cur.half) { PG8_MMA(1, 0, At, B0); PG8_MMA(1, 1, At, B1); } PG8_BAR; PG8_SCHED;
        }
        if (wr == 0) PG8_BAR;
        E(acc, cur, wr, wc, fr, fq);
        if (!has_next) break;
#pragma unroll
        for (int a = 0; a < 2; ++a)
#pragma unroll
            for (int b = 0; b < 2; ++b)
#pragma unroll
                for (int m = 0; m < 4; ++m)
#pragma unroll
                    for (int n = 0; n < 2; ++n) acc[a][b][m][n] = (f32x4){0.f, 0.f, 0.f, 0.f};
        cur = nxt; cA = nA; cB = nB; cHs = nHs; ++ui;
        if (wr == 1) PG8_BAR;
    }
    PG8_WAIT_V(0);
    PG8_BAR;
#undef PG8_SA
#undef PG8_SB
#undef PG8_GLDS
#undef PG8_STAGEB
#undef PG8_STAGEA
#undef PG8_GFILL
#undef PG8_LDA
#undef PG8_LDB
#undef PG8_MMA
#undef PG8_WAIT_V
#undef PG8_WAIT_L
#undef PG8_BAR
#undef PG8_SCHED
}

#define EPI_LOOP_BEGIN \
    const int row0 = u.pm * BM + u.rofs + wr * 64 + fr; const int colb = wc * 32 + 8 * fq; \
    _Pragma("unroll") for (int ai = 0; ai < 2; ++ai) if (ai == 0 || !u.half) _Pragma("unroll") for (int m = 0; m < 4; ++m) { const int row = row0 + ai * HALF + m * 16; \
    _Pragma("unroll") for (int bj = 0; bj < 2; ++bj) { const int colt = bj * HALF + colb; const f32x4 v0 = acc[ai][bj][m][0], v1 = acc[ai][bj][m][1];
#define EPI_LOOP_END } }

struct EpiBf16 {
    bf16* O; int ldc;
    DI void operator()(const f32x4 (&acc)[2][2][4][2], const Unit& u, int wr, int wc, int fr, int fq) const {
        EPI_LOOP_BEGIN
            u32x4 w; w.x = pk2(v0[0], v0[1]); w.y = pk2(v0[2], v0[3]); w.z = pk2(v1[0], v1[1]); w.w = pk2(v1[2], v1[3]);
            __builtin_nontemporal_store(w, (u32x4*)(O + (size_t)row * ldc + u.pn * BM + colt));
        EPI_LOOP_END
    }
};
struct EpiResid {
    const float* srcf; const bf16* srcb; bf16* res; float sc;
    DI void operator()(const f32x4 (&acc)[2][2][4][2], const Unit& u, int wr, int wc, int fr, int fq) const {
        EPI_LOOP_BEGIN
            const size_t o = (size_t)row * DM + u.pn * BM + colt;
            f32x4 s0, s1;
            if (srcf) { s0 = *(const f32x4*)(srcf + o); s1 = *(const f32x4*)(srcf + o + 4); }
            else { const u32x4 w = *(const u32x4*)(srcb + o); s0 = (f32x4){bflo(w.x), bfhi(w.x), bflo(w.y), bfhi(w.y)}; s1 = (f32x4){bflo(w.z), bfhi(w.z), bflo(w.w), bfhi(w.w)}; }
            s0 = s0 + v0 * sc; s1 = s1 + v1 * sc;
            u32x4 w; w.x = pk2(s0[0], s0[1]); w.y = pk2(s0[2], s0[3]); w.z = pk2(s1[0], s1[1]); w.w = pk2(s1[2], s1[3]);
            *(u32x4*)(res + o) = w;
        EPI_LOOP_END
    }
};
struct EpiCmp1 {
    bf16* hid;
    DI void operator()(const f32x4 (&acc)[2][2][4][2], const Unit& u, int wr, int wc, int fr, int fq) const {
        EPI_LOOP_BEGIN
            u32x4 w; w.x = pk2(v0[0], v0[1]); w.y = pk2(v0[2], v0[3]); w.z = pk2(v1[0], v1[1]); w.w = pk2(v1[2], v1[3]);
            *(u32x4*)(hid + (size_t)u.kind * 2048 * 256 + (size_t)row * 256 + colt) = w;
        EPI_LOOP_END
    }
};
struct EpiCmp2 {
    float* kcl; float* vcl;
    DI void operator()(const f32x4 (&acc)[2][2][4][2], const Unit& u, int wr, int wc, int fr, int fq) const {
        float* dst = u.kind ? vcl : kcl;
        EPI_LOOP_BEGIN
            if (colt < 64) { const bool z = (row & 255) == 255; const f32x4 zz = {0.f, 0.f, 0.f, 0.f};
                *(f32x4*)(dst + (size_t)row * 64 + colt) = z ? zz : v0; *(f32x4*)(dst + (size_t)row * 64 + colt + 4) = z ? zz : v1; }
        EPI_LOOP_END
    }
};
struct EpiXqkv {
    bf16* xq; bf16* xkv; const LAS float* rstab;
    DI void operator()(const f32x4 (&acc)[2][2][4][2], const Unit& u, int wr, int wc, int fr, int fq) const {
        bf16* dst = u.kind ? xkv : xq; const int ldc = u.kind ? 512 : 256;
        EPI_LOOP_BEGIN
            const float rs = u.kind ? 1.f : rstab[u.e * BM + row - u.pm * BM];
            u32x4 w; w.x = pk2(v0[0] * rs, v0[1] * rs); w.y = pk2(v0[2] * rs, v0[3] * rs); w.z = pk2(v1[0] * rs, v1[1] * rs); w.w = pk2(v1[2] * rs, v1[3] * rs);
            *(u32x4*)(dst + (size_t)row * ldc + u.pn * BM + colt) = w;
        EPI_LOOP_END
    }
};
struct EpiSwiglu {
    bf16* act; const int* slottok; const float* rsv;
    DI void operator()(const f32x4 (&acc)[2][2][4][2], const Unit& u, int wr, int wc, int fr, int fq) const {
        const int row0 = u.pm * BM + u.rofs + wr * 64 + fr; const int colb = wc * 32 + 8 * fq;
        float rsr[2][4];
#pragma unroll
        for (int ai = 0; ai < 2; ++ai)
#pragma unroll
            for (int m = 0; m < 4; ++m) rsr[ai][m] = rsv[slottok[row0 + ((ai == 0 || !u.half) ? ai * HALF : 0) + m * 16]];
#pragma unroll
        for (int ai = 0; ai < 2; ++ai) if (ai == 0 || !u.half)
#pragma unroll
            for (int m = 0; m < 4; ++m) { const int row = row0 + ai * HALF + m * 16; const float rs = rsr[ai][m];
                const f32x4 g0 = acc[ai][0][m][0] * rs, g1 = acc[ai][0][m][1] * rs, u0 = acc[ai][1][m][0] * rs, u1 = acc[ai][1][m][1] * rs;
                u32x4 w; w.x = pk2(silu(g0[0]) * u0[0], silu(g0[1]) * u0[1]); w.y = pk2(silu(g0[2]) * u0[2], silu(g0[3]) * u0[3]);
                w.z = pk2(silu(g1[0]) * u1[0], silu(g1[1]) * u1[1]); w.w = pk2(silu(g1[2]) * u1[2], silu(g1[3]) * u1[3]);
                *(u32x4*)(act + (size_t)row * 256 + u.pn * 128 + colb) = w; }
    }
};
}

struct Args { const float* in[33]; float* out; unsigned char* ws; int l_lo, l_hi, ph_lo, ph_hi, pro, fin; };

struct Ctx {
    const float* const __attribute__((address_space(4)))* in; float* out; unsigned char* ws; LAS unsigned char* lds;
    int tid, lane, wave, G, blk, gw, ngw, l;
    DI bf16* wsb(size_t off) const { return (bf16*)(ws + off); }
    DI float* wsf(size_t off) const { return (float*)(ws + off); }
    DI int* wsi(size_t off) const { return (int*)(ws + off); }
    DI bf16* ob16(size_t off) const { return (bf16*)((unsigned char*)out + off); }
    DI float* of32(size_t off) const { return (float*)((unsigned char*)out + off); }
};

DI int win_src(int n) {
    if (n < 640) return n;
    if (n < 1408) return n + 12;
    if (n < 2176) return n + 20;
    if (n < 3200) return n + 28;
    if (n < 3212) return n - 3200 + 640;
    if (n < 3220) return n - 3212 + 1420;
    if (n < 3228) return n - 3220 + 2196;
    return -1;
}
DI void transpose_load(const float* W, int Nsrc, int kb, int lane, int sc, const float* kgain, float (&v)[32]) {
    const int k0 = 64 * kb;
#pragma unroll
    for (int i = 0; i < 32; ++i) { const int kk = 2 * i + (lane >> 5); v[i] = (sc >= 0) ? __builtin_nontemporal_load(W + (size_t)(k0 + kk) * Nsrc + sc) : 0.f; }
    if (kgain) {
#pragma unroll
        for (int i = 0; i < 32; ++i) v[i] *= kgain[k0 + 2 * i + (lane >> 5)]; }
}
DI void transpose_store(const float (&v)[32], int K, bf16* WT, LAS float* scr, int kb, int nb, int lane) {
    const int k0 = 64 * kb, n0 = 32 * nb;
#pragma unroll
    for (int i = 0; i < 32; ++i) { const int kk = 2 * i + (lane >> 5); scr[kk * 33 + (lane & 31)] = v[i]; }
    LDS_WAIT();
    const int c = lane & 7;
#pragma unroll
    for (int j = 0; j < 4; ++j) { const int n = (lane >> 3) + 8 * j; const LAS float* s = scr + (8 * c) * 33 + n;
        u32x4 o; o.x = pk2(s[0 * 33], s[1 * 33]); o.y = pk2(s[2 * 33], s[3 * 33]); o.z = pk2(s[4 * 33], s[5 * 33]); o.w = pk2(s[6 * 33], s[7 * 33]);
        *(u32x4*)(WT + (size_t)(n0 + n) * K + k0 + 8 * c) = o; }
    LDS_WAIT();
}
DI void transpose_item(const float* W, int K, int Nsrc, bf16* WT, LAS float* scr, int kb, int nb, int lane, int sc, const float* kgain = nullptr) {
    float v[32]; transpose_load(W, Nsrc, kb, lane, sc, kgain, v); transpose_store(v, K, WT, scr, kb, nb, lane);
}

DI void row_load(const float* p, int lane, f32x4 (&v)[4]) {
#pragma unroll
    for (int j = 0; j < 4; ++j) v[j] = *(const f32x4*)(p + 4 * lane + 256 * j);
}
DI void row_load_bf(const bf16* p, int lane, f32x4 (&v)[4]) {
#pragma unroll
    for (int j = 0; j < 4; ++j) { const u32x2 w = *(const u32x2*)(p + 4 * lane + 256 * j); v[j] = (f32x4){bflo(w.x), bfhi(w.x), bflo(w.y), bfhi(w.y)}; }
}
DI void row_store_bf(bf16* p, int lane, const f32x4 (&v)[4]) {
#pragma unroll
    for (int j = 0; j < 4; ++j) { u32x2 w; w.x = pk2(v[j][0], v[j][1]); w.y = pk2(v[j][2], v[j][3]); *(u32x2*)(p + 4 * lane + 256 * j) = w; }
}
DI float row_ss(const f32x4 (&v)[4]) { float s = 0.f;
#pragma unroll
    for (int j = 0; j < 4; ++j) s += (v[j][0] * v[j][0] + v[j][1] * v[j][1]) + (v[j][2] * v[j][2] + v[j][3] * v[j][3]);
    return wsum(s); }
DI void row_norm_store(const f32x4 (&v)[4], float rs, const float* g, bf16* o, int lane) {
#pragma unroll
    for (int j = 0; j < 4; ++j) { const f32x4 gg = *(const f32x4*)(g + 4 * lane + 256 * j);
        u32x2 w; w.x = pk2(v[j][0] * rs * gg[0], v[j][1] * rs * gg[1]); w.y = pk2(v[j][2] * rs * gg[2], v[j][3] * rs * gg[3]);
        *(u32x2*)(o + 4 * lane + 256 * j) = w; }
}
DI void phase_prologue(const Ctx& c) {
    LAS float* scr = (LAS float*)(c.lds + c.wave * 16384);
    constexpr int I_WIN = 16 * 104, I_WOUT = 16 * 32, I_XQ = 16 * 8, I_XKV = 16 * 16, I_XO = 4 * 32, I_C1 = 32 * 8, I_C2 = 2 * 8;
    constexpr int PER_L = I_WIN + I_WOUT + I_XQ + I_XKV + I_XO + 2 * I_C1 + 2 * I_C2;
    for (int it = c.gw; it < 2 * PER_L; it += c.ngw) {
        const int l = it / PER_L; int r = it % PER_L; const int ln = c.lane & 31;
        if (r < I_WIN) { const int kb = r / 104, nb = r % 104; transpose_item(c.in[3] + (size_t)l * DM * 3228, DM, 3228, c.wsb(WS_WIN + l * WIN_L), scr, kb, nb, c.lane, win_src(32 * nb + ln)); continue; } r -= I_WIN;
        if (r < I_WOUT) { const int kb = r / 32, nb = r % 32; transpose_item(c.in[4] + (size_t)l * DM * DM, DM, DM, c.wsb(WS_WOUT + (size_t)l * 2 * MiB), scr, kb, nb, c.lane, 32 * nb + ln); continue; } r -= I_WOUT;
        if (r < I_XQ) { const int kb = r / 8, nb = r % 8; transpose_item(c.in[21] + (size_t)l * DM * 256, DM, 256, c.wsb(WS_XWQ + (size_t)l * 512 * KiB), scr, kb, nb, c.lane, 32 * nb + ln, c.in[19] + (size_t)l * DM); continue; } r -= I_XQ;
        if (r < I_XKV) { const int kb = r / 16, nb = r % 16; transpose_item(c.in[22] + (size_t)l * DM * 512, DM, 512, c.wsb(WS_XWKV + (size_t)l * MiB), scr, kb, nb, c.lane, 32 * nb + ln); continue; } r -= I_XKV;
        if (r < I_XO) { const int kb = r / 32, nb = r % 32; transpose_item(c.in[24] + (size_t)l * 256 * DM, 256, DM, c.wsb(WS_XWO + (size_t)l * 512 * KiB), scr, kb, nb, c.lane, 32 * nb + ln); continue; } r -= I_XO;
        if (r < 2 * I_C1) { const int j = r / I_C1, q = r % I_C1, kb = q / 8, nb = q % 8; const int n = 32 * nb + ln;
            transpose_item(c.in[7] + (size_t)(l * 2 + j) * 2048 * 128, 2048, 128, c.wsb(WS_CW1 + (size_t)(l * 2 + j) * MiB), scr, kb, nb, c.lane, n < 128 ? n : -1); continue; } r -= 2 * I_C1;
        { const int j = r / I_C2, q = r % I_C2, kb = q / 8, nb = q % 8; const int n = 32 * nb + ln;
            transpose_item(c.in[8] + (size_t)(l * 2 + j) * 128 * 64, 128, 64, c.wsb(WS_CW2 + (size_t)(l * 2 + j) * 64 * KiB), scr, kb, nb, c.lane, n < 64 ? n : -1); }
    }
    for (int it = c.gw; it < 2 * 2048; it += c.ngw) { const int l = it >> 11, row = it & 2047;
        f32x4 v[4]; row_load(c.in[1] + (size_t)row * DM, c.lane, v);
        const float rs = rsq(row_ss(v) * (1.f / DM) + EPS);
        row_norm_store(v, rs, c.in[20] + (size_t)l * DM, c.wsb(WS_MEMN + (size_t)l * 4 * MiB) + (size_t)row * DM, c.lane); }
    const int gt = c.blk * NTHREADS + c.tid, ngt = c.G * NTHREADS;
    for (int i = c.gw; i < 4 * 256; i += c.ngw) { const int lj = i >> 8, n = i & 255; float s = 0.f;
        if (n < 128) { const float* pe = c.in[6] + (size_t)lj * 2048; const float* w1 = c.in[7] + (size_t)lj * 2048 * 128 + n;
#pragma unroll 8
            for (int k = c.lane; k < 2048; k += 64) s += pe[k] * w1[(size_t)k * 128];
            s = wsum(s); }
        if (c.lane == 0) c.wsf(WS_CB1)[i] = s; }
    float* cosA = c.wsf(WS_ROPE); float* sinA = cosA + 4096 * 32; float* cosD = sinA + 4096 * 32; float* sinD = cosD + 4096 * 16;
    for (int i = gt; i < 4096 * 48; i += ngt) {
        const bool isA = i < 4096 * 32; const int j = isA ? i : i - 4096 * 32; const int pos = isA ? (j >> 5) : (j >> 4), fi = isA ? (j & 31) : (j & 15); const int dim = isA ? 64 : 32;
        const float invf = (float)exp2(-((double)(2 * fi) / (double)dim) * 13.287712379549449);
        const float ang = (float)pos * invf; const double rev = (double)ang * 0.15915494309189535; const float fr = (float)(rev - floor(rev));
        const float cs = __builtin_amdgcn_cosf(fr), sn = __builtin_amdgcn_sinf(fr);
        if (isA) { cosA[j] = cs; sinA[j] = sn; } else { cosD[j] = cs; sinD[j] = sn; } }
    for (int i = gt; i < 2 * 64 * 1024; i += ngt) { const int l = i >> 16, r = i & 65535, e = r >> 10, k = r & 1023;
        float v = 0.f; if (e < 4) v = c.in[26][(size_t)l * DM * 4 + k * 4 + e]; else if (e < 36) v = c.in[28][(size_t)l * DM * 32 + k * 32 + (e - 4)];
        v *= c.in[25][(size_t)l * DM + k]; const bf16 hi = f2bf(v); const bf16 lo = f2bf(v - bf2f(hi));
        c.wsb(WS_WRT)[(size_t)(l * 2) * 65536 + r] = hi; c.wsb(WS_WRT)[(size_t)(l * 2 + 1) * 65536 + r] = lo; }
}

DI void convert_moe_weights(const Ctx& c, int it0, int it1, int gw0, int ngw0) {
    LAS float* scr = (LAS float*)(c.lds + c.wave * 16384);
    constexpr int I13 = 16 * 16, I2 = 4 * 32;
    const int l = c.l; const int ln = c.lane & 31;
    auto dec = [&](int it, const float*& src, int& nsrc, int& K, bf16*& dst, int& kb, int& nb, int& sc, const float*& kg) {
        const int e = it / (I13 + I2); int r = it % (I13 + I2);
        if (r < I13) { kb = r / 16; nb = r % 16; const int n0 = 32 * nb; const int pn = n0 >> 8, bj = (n0 >> 7) & 1; sc = pn * 128 + (n0 & 127) + ln;
            src = (bj ? c.in[31] : c.in[30]) + (size_t)(l * 32 + e) * DM * 256; nsrc = 256; K = DM; dst = c.wsb(WS_MW13 + (size_t)e * MiB); kg = c.in[25] + (size_t)l * DM; }
        else { r -= I13; kb = r / 32; nb = r % 32; sc = 32 * nb + ln;
            src = c.in[32] + (size_t)(l * 32 + e) * 256 * DM; nsrc = DM; K = 256; dst = c.wsb(WS_MW2 + (size_t)e * 512 * KiB); kg = nullptr; } };
    for (int it = it0 + gw0; it < it1; it += 2 * ngw0) {
        const float* sa; const float* sb; const float* ga; const float* gb; bf16* da; bf16* db; int na, nb_, Ka, Kb, kba, kbb, nba, nbb, sca, scb;
        const int itb = it + ngw0; const bool hasb = itb < it1;
        dec(it, sa, na, Ka, da, kba, nba, sca, ga); dec(hasb ? itb : it, sb, nb_, Kb, db, kbb, nbb, scb, gb);
        float va[32], vb[32];
        transpose_load(sa, na, kba, c.lane, sca, ga, va); transpose_load(sb, nb_, kbb, c.lane, scb, gb, vb);
        transpose_store(va, Ka, da, scr, kba, nba, c.lane);
        if (hasb) transpose_store(vb, Kb, db, scr, kbb, nbb, c.lane);
    }
}

DI void moe_combine_row(const Ctx& c, int row, f32x4 (&v)[4]) {
    const int* ts = c.wsi(WS_TOKS) + 2 * row; const float* tw = c.wsf(WS_TOKW) + 2 * row;
    const int sa = ts[0], sb = ts[1]; const float wa = tw[0], wb = tw[1];
    const bf16* ya = c.wsb(WS_YMOE) + (size_t)sa * DM; const bf16* yb = c.wsb(WS_YMOE) + (size_t)sb * DM;
#pragma unroll
    for (int j = 0; j < 4; ++j) { const u32x2 a = *(const u32x2*)(ya + 4 * c.lane + 256 * j), b = *(const u32x2*)(yb + 4 * c.lane + 256 * j);
        v[j][0] += wa * bflo(a.x) + wb * bflo(b.x); v[j][1] += wa * bfhi(a.x) + wb * bfhi(b.x);
        v[j][2] += wa * bflo(a.y) + wb * bflo(b.y); v[j][3] += wa * bfhi(a.y) + wb * bfhi(b.y); }
}
DI void moe_combine_vals(const Ctx& c, int sa, int sb, float wa, float wb, f32x4 (&v)[4]) {
    const bf16* ya = c.wsb(WS_YMOE) + (size_t)sa * DM; const bf16* yb = c.wsb(WS_YMOE) + (size_t)sb * DM;
#pragma unroll
    for (int j = 0; j < 4; ++j) { const u32x2 a = *(const u32x2*)(ya + 4 * c.lane + 256 * j), b = *(const u32x2*)(yb + 4 * c.lane + 256 * j);
        v[j][0] += wa * bflo(a.x) + wb * bflo(b.x); v[j][1] += wa * bfhi(a.x) + wb * bfhi(b.x);
        v[j][2] += wa * bflo(a.y) + wb * bflo(b.y); v[j][3] += wa * bfhi(a.y) + wb * bfhi(b.y); }
}
DI void moe_rows_load(const Ctx& c, int sa, int sb, u32x2 (&a)[4], u32x2 (&b)[4]) {
    const bf16* ya = c.wsb(WS_YMOE) + (size_t)sa * DM; const bf16* yb = c.wsb(WS_YMOE) + (size_t)sb * DM;
#pragma unroll
    for (int j = 0; j < 4; ++j) { a[j] = __builtin_nontemporal_load((const u32x2*)(ya + 4 * c.lane + 256 * j)); b[j] = __builtin_nontemporal_load((const u32x2*)(yb + 4 * c.lane + 256 * j)); }
}
DI void moe_rows_apply(float wa, float wb, const u32x2 (&a)[4], const u32x2 (&b)[4], f32x4 (&v)[4]) {
#pragma unroll
    for (int j = 0; j < 4; ++j) { v[j][0] += wa * bflo(a[j].x) + wb * bflo(b[j].x); v[j][1] += wa * bfhi(a[j].x) + wb * bfhi(b[j].x);
        v[j][2] += wa * bflo(a[j].y) + wb * bflo(b[j].y); v[j][3] += wa * bfhi(a[j].y) + wb * bfhi(b[j].y); }
}
DI void phase_norm_mix(const Ctx& c, bool dry) {
    const float* g = c.in[2] + (size_t)c.l * DM; bf16* hn = c.wsb(WS_HN);
    if (c.l == 0) {
#pragma unroll 1
        for (int row0 = c.gw; row0 < T; row0 += 4 * c.ngw) {
            f32x4 v[4][4];
#pragma unroll
            for (int j = 0; j < 4; ++j) { const int row = row0 + j * c.ngw < T ? row0 + j * c.ngw : row0; const float* p_ = c.in[0] + (size_t)row * DM;
#pragma unroll
                for (int q = 0; q < 4; ++q) v[j][q] = __builtin_nontemporal_load((const f32x4*)(p_ + 4 * c.lane + 256 * q)); }
#pragma unroll
            for (int j = 0; j < 4; ++j) { const int row = row0 + j * c.ngw; if (row >= T) break;
                const float rs = rsq(row_ss(v[j]) * (1.f / DM) + EPS); row_norm_store(v[j], rs, g, hn + (size_t)row * DM, c.lane); } }
        return; }
    for (int base = c.gw; base < T; base += 64 * c.ngw) {
        const int myrow = base + c.lane * c.ngw; int sa_ = 0, sb_ = 0; float wa_ = 0.f, wb_ = 0.f;
        if (myrow < T) { const int* ts = c.wsi(WS_TOKS) + 2 * myrow; const float* tw = c.wsf(WS_TOKW) + 2 * myrow; sa_ = ts[0]; sb_ = ts[1]; wa_ = tw[0]; wb_ = tw[1]; }
#pragma unroll 1
        for (int k0 = 0; k0 < 64; k0 += 4) {
            if (base + k0 * c.ngw >= T) break;
            f32x4 v[4][4]; u32x2 ea[4][4], eb[4][4];
#pragma unroll
            for (int j = 0; j < 4; ++j) { const int k = k0 + j; const int row = base + k * c.ngw < T ? base + k * c.ngw : base + k0 * c.ngw;
                const int sa = __builtin_amdgcn_readlane(sa_, k), sb = __builtin_amdgcn_readlane(sb_, k);
                row_load_bf(c.wsb(WS_RES) + (size_t)row * DM, c.lane, v[j]); moe_rows_load(c, sa, sb, ea[j], eb[j]); }
#pragma unroll
            for (int j = 0; j < 4; ++j) { const int k = k0 + j; const int row = base + k * c.ngw; if (row >= T) break;
                const float wa = __builtin_bit_cast(float, __builtin_amdgcn_readlane(__builtin_bit_cast(int, wa_), k)), wb = __builtin_bit_cast(float, __builtin_amdgcn_readlane(__builtin_bit_cast(int, wb_), k));
                moe_rows_apply(wa, wb, ea[j], eb[j], v[j]);
                if (!dry) row_store_bf(c.wsb(WS_RES) + (size_t)row * DM, c.lane, v[j]);
                const float rs = rsq(row_ss(v[j]) * (1.f / DM) + EPS);
                row_norm_store(v[j], rs, g, hn + (size_t)row * DM, c.lane); } }
    }
}
DI void phase_final(const Ctx& c) {
    for (int base = c.gw; base < T; base += 64 * c.ngw) {
        const int myrow = base + c.lane * c.ngw; int sa_ = 0, sb_ = 0; float wa_ = 0.f, wb_ = 0.f;
        if (myrow < T) { const int* ts = c.wsi(WS_TOKS) + 2 * myrow; const float* tw = c.wsf(WS_TOKW) + 2 * myrow; sa_ = ts[0]; sb_ = ts[1]; wa_ = tw[0]; wb_ = tw[1]; }
#pragma unroll 1
        for (int k0 = 0; k0 < 64; k0 += 4) {
            if (base + k0 * c.ngw >= T) break;
            f32x4 v[4][4]; u32x2 ea[4][4], eb[4][4];
#pragma unroll
            for (int j = 0; j < 4; ++j) { const int k = k0 + j; const int row = base + k * c.ngw < T ? base + k * c.ngw : base + k0 * c.ngw;
                const int sa = __builtin_amdgcn_readlane(sa_, k), sb = __builtin_amdgcn_readlane(sb_, k);
                { const bf16* rp_ = c.wsb(WS_RES) + (size_t)row * DM;
#pragma unroll
                  for (int q = 0; q < 4; ++q) { const u32x2 w_ = __builtin_nontemporal_load((const u32x2*)(rp_ + 4 * c.lane + 256 * q)); v[j][q] = (f32x4){bflo(w_.x), bfhi(w_.x), bflo(w_.y), bfhi(w_.y)}; } }
                moe_rows_load(c, sa, sb, ea[j], eb[j]); }
#pragma unroll
            for (int j = 0; j < 4; ++j) { const int k = k0 + j; const int row = base + k * c.ngw; if (row >= T) break;
                const float wa = __builtin_bit_cast(float, __builtin_amdgcn_readlane(__builtin_bit_cast(int, wa_), k)), wb = __builtin_bit_cast(float, __builtin_amdgcn_readlane(__builtin_bit_cast(int, wb_), k));
                moe_rows_apply(wa, wb, ea[j], eb[j], v[j]);
#pragma unroll
                for (int q = 0; q < 4; ++q) *(f32x4*)(c.out + (size_t)row * DM + 4 * c.lane + 256 * q) = v[j][q]; } }
    }
}
DI void phase_prep(const Ctx& c, bool dry) {
    const float* cosA = c.wsf(WS_ROPE); const float* sinA = cosA + 4096 * 32; const float* cosD = sinA + 4096 * 32; const float* sinD = cosD + 4096 * 16;
    const float* ng = c.in[5] + (size_t)c.l * 256;
    const float* dg = c.in[16] + (size_t)c.l * 64;
    bf16* kcr = c.wsb(WS_KCR); bf16* vcr = c.wsb(WS_VCR);
    const int L = c.lane;
    const int hdA = L >> 3, chA = L & 7; const int colA = (hdA < 4 ? A_Q + 64 * hdA : (hdA == 4 ? A_KS : (hdA == 5 ? A_KW : (hdA == 6 ? A_KC : A_VC)))) + 8 * chA;
    const float* gA = ng + (hdA < 4 ? 0 : (hdA == 4 ? 128 : 192)) + 8 * chA; const int ddA = (chA & 3) * 8;
    const int idB = L >> 2, chB = L & 3; const bool isq = idB < 8; const int colB = (isq ? D_Q : D_K) + 32 * (idB & 7) + 8 * chB;
    const float* gB = dg + (isq ? 0 : 32) + 8 * chB; const int ddB = (chB & 1) * 8;
    float gav[8], gbv[8];
#pragma unroll
    for (int i = 0; i < 8; ++i) { gav[i] = (hdA < 6) ? gA[i] : 0.f; gbv[i] = gB[i]; }
    constexpr int RB = 4;
#pragma unroll 1
    for (int row0 = c.gw; row0 < T; row0 += RB * c.ngw) {
        u32x4 va_[RB], vb_[RB]; f32x4 tA[RB][4], tB[RB][4];
#pragma unroll
        for (int j = 0; j < RB; ++j) { const int row = row0 + j * c.ngw < T ? row0 + j * c.ngw : row0; const int pos = row & (SEQ - 1); const bf16* pr = c.wsb(WS_PROJ) + (size_t)row * PC;
            va_[j] = *(const u32x4*)(pr + colA); vb_[j] = *(const u32x4*)(pr + colB);
            tA[j][0] = *(const f32x4*)(cosA + pos * 32 + ddA); tA[j][1] = *(const f32x4*)(cosA + pos * 32 + ddA + 4); tA[j][2] = *(const f32x4*)(sinA + pos * 32 + ddA); tA[j][3] = *(const f32x4*)(sinA + pos * 32 + ddA + 4);
            tB[j][0] = *(const f32x4*)(cosD + pos * 16 + ddB); tB[j][1] = *(const f32x4*)(cosD + pos * 16 + ddB + 4); tB[j][2] = *(const f32x4*)(sinD + pos * 16 + ddB); tB[j][3] = *(const f32x4*)(sinD + pos * 16 + ddB + 4); }
#pragma unroll
        for (int j = 0; j < RB; ++j) { const int row = row0 + j * c.ngw; if (row >= T) break;
        bf16* pr = c.wsb(WS_PROJ) + (size_t)row * PC;
        const u32x4 va = va_[j], vb = vb_[j];
        const f32x4 ca0 = tA[j][0], ca1 = tA[j][1], sa0 = tA[j][2], sa1 = tA[j][3];
        const f32x4 cb0 = tB[j][0], cb1 = tB[j][1], sb0 = tB[j][2], sb1 = tB[j][3];
        { float x[8] = {bflo(va.x), bfhi(va.x), bflo(va.y), bfhi(va.y), bflo(va.z), bfhi(va.z), bflo(va.w), bfhi(va.w)}; float ss = 0.f;
#pragma unroll
            for (int i = 0; i < 8; ++i) ss += x[i] * x[i];
            ss += shx(ss, 1); ss += shx(ss, 2); ss += shx(ss, 4);
            const float rs = rsq(ss * (1.f / 64) + EPS); const float cs[8] = {ca0[0], ca0[1], ca0[2], ca0[3], ca1[0], ca1[1], ca1[2], ca1[3]}; const float sn[8] = {sa0[0], sa0[1], sa0[2], sa0[3], sa1[0], sa1[1], sa1[2], sa1[3]};
            float o[8];
#pragma unroll
            for (int i = 0; i < 8; ++i) { const float y = x[i] * rs * gav[i]; const float p = shx(y, 4); float v = (chA < 4) ? y * cs[i] - p * sn[i] : y * cs[i] + p * sn[i]; if (hdA < 4) v *= QSCALE; o[i] = dry ? x[i] : v; }
            if (hdA < 6) *(u32x4*)(pr + colA) = f8_to_bf(o);
            else *(u32x4*)((hdA == 6 ? kcr : vcr) + (size_t)row * 64 + 8 * chA) = va; }
        { float x[8] = {bflo(vb.x), bfhi(vb.x), bflo(vb.y), bfhi(vb.y), bflo(vb.z), bfhi(vb.z), bflo(vb.w), bfhi(vb.w)}; float ss = 0.f;
#pragma unroll
            for (int i = 0; i < 8; ++i) ss += x[i] * x[i];
            ss += shx(ss, 1); ss += shx(ss, 2);
            const float rs = rsq(ss * (1.f / 32) + EPS); const float cs[8] = {cb0[0], cb0[1], cb0[2], cb0[3], cb1[0], cb1[1], cb1[2], cb1[3]}; const float sn[8] = {sb0[0], sb0[1], sb0[2], sb0[3], sb1[0], sb1[1], sb1[2], sb1[3]};
            float o[8];
#pragma unroll
            for (int i = 0; i < 8; ++i) { const float y = x[i] * rs * gbv[i]; const float p = shx(y, 2); float v = (chB < 2) ? y * cs[i] - p * sn[i] : y * cs[i] + p * sn[i]; if (isq) v *= DSCALE; o[i] = dry ? x[i] : v; }
            *(u32x4*)(pr + colB) = f8_to_bf(o); }
        }
    }
}

DI void cmp_finish_rows(const Ctx& c, int kind, int row0) {
    const float* cosA = c.wsf(WS_ROPE); const float* sinA = cosA + 4096 * 32;
    const float* g = c.in[5] + (size_t)c.l * 256 + 64;
    for (int row = row0 + c.wave; row < row0 + 256; row += NWAVES) {
        if (kind) { c.wsb(WS_VCN)[(size_t)row * 64 + c.lane] = f2bf(c.wsf(WS_VCL)[(size_t)row * 64 + c.lane]); continue; }
        const int kg = row & 255; int ps = 16 * kg + 31; ps = ps > 4095 ? 4095 : ps;
        const int d = c.lane & 31, hh = c.lane >> 5;
        const float x = c.wsf(WS_KCL)[(size_t)row * 64 + c.lane];
        float ss = wsum(x * x);
        const float y = x * rsq(ss * (1.f / 64) + EPS) * g[c.lane];
        const float pr = shx(y, 32);
        const float cs = cosA[ps * 32 + d], sn = sinA[ps * 32 + d];
        const float o = hh ? y * cs + pr * sn : y * cs - pr * sn;
        c.wsb(WS_KCN)[(size_t)row * 64 + c.lane] = f2bf(o);
    }
}

DI void phase_cmp_stage2(const Ctx& c, int it0, int it1, int gw0, int ngw0) {
    const float* cosA = c.wsf(WS_ROPE); const float* sinA = cosA + 4096 * 32;
    const float* g = c.in[5] + (size_t)c.l * 256 + 64; const int d = c.lane & 31, hh = c.lane >> 5; const float gl = g[c.lane];
    float w2r[128]; { const float* w2 = c.in[8] + (size_t)(c.l * 2 + (it0 >> 11)) * 128 * 64 + c.lane;
#pragma unroll
        for (int k = 0; k < 128; ++k) w2r[k] = w2[k * 64]; }
    for (int it = it0 + gw0; it < it1; it += ngw0) { const int kind = it >> 11, row = it & 2047; const int kg = row & 255;
        const unsigned hraw = *(const unsigned*)(c.wsb(WS_HID) + (size_t)kind * 2048 * 256 + (size_t)row * 256 + 2 * c.lane);
        const float* b1 = c.wsf(WS_CB1) + c.l * 512 + kind * 256 + 2 * c.lane;
        const unsigned hv = pk2(gelu_tanh(bflo(hraw) + b1[0]), gelu_tanh(bfhi(hraw) + b1[1]));
        float a0 = 0.f, a1 = 0.f;
#pragma unroll
        for (int k2 = 0; k2 < 64; ++k2) { const unsigned hk = (unsigned)__builtin_amdgcn_readlane((int)hv, k2); a0 += bflo(hk) * w2r[2 * k2]; a1 += bfhi(hk) * w2r[2 * k2 + 1]; }
        float x = (kg == 255) ? 0.f : a0 + a1;
        if (kind) { c.wsb(WS_VCN)[(size_t)row * 64 + c.lane] = f2bf(x); continue; }
        int ps = 16 * kg + 31; ps = ps > 4095 ? 4095 : ps;
        const float ss = wsum(x * x); const float y = x * rsq(ss * (1.f / 64) + EPS) * gl; const float pr = shx(y, 32);
        const float cs = cosA[ps * 32 + d], sn = sinA[ps * 32 + d];
        c.wsb(WS_KCN)[(size_t)row * 64 + c.lane] = f2bf(hh ? y * cs + pr * sn : y * cs - pr * sn);
    }
}

constexpr int KP = 72, VP = 68;
constexpr int KT_BYTES = 64 * KP * 2, VT_BYTES = 64 * VP * 2;

DI bf16x8 pack8(const f32x16& s, int st) {
    u32x4 p; p.x = pk2(s[8 * st + 0], s[8 * st + 1]); p.y = pk2(s[8 * st + 2], s[8 * st + 3]); p.z = pk2(s[8 * st + 4], s[8 * st + 5]); p.w = pk2(s[8 * st + 6], s[8 * st + 7]);
    return __builtin_bit_cast(bf16x8, p);
}
DI bf16x8 vfrag(const LAS bf16* p) {
    const u32x2 lo = *(const LAS u32x2*)p, hi = *(const LAS u32x2*)(p + 8);
    u32x4 r; r.x = lo.x; r.y = lo.y; r.z = hi.x; r.w = hi.y; return __builtin_bit_cast(bf16x8, r);
}
template <int NKS>
DI void qk_tile(f32x16& s0, f32x16& s1, const LAS bf16* Kt, int koff, const bf16x8* qf, int r32, int hi) {
#pragma unroll
    for (int i = 0; i < 16; ++i) { s0[i] = 0.f; s1[i] = 0.f; }
#pragma unroll
    for (int s = 0; s < NKS; ++s) {
        const bf16x8 a0 = *(const LAS bf16x8*)(Kt + r32 * KP + koff + 16 * s + 8 * hi);
        const bf16x8 a1 = *(const LAS bf16x8*)(Kt + (32 + r32) * KP + koff + 16 * s + 8 * hi);
        s0 = MFMA32(a0, qf[s], s0); s1 = MFMA32(a1, qf[s], s1);
    }
    __builtin_amdgcn_sched_barrier(0);
}
DI void pv_tile(f32x16& o0, f32x16& o1, const bf16x8 p00, const bf16x8 p01, const bf16x8 p10, const bf16x8 p11, const LAS bf16* Vt, int r32, int hi) {
    const LAS bf16* v0 = Vt + r32 * VP + 4 * hi; const LAS bf16* v1 = Vt + (32 + r32) * VP + 4 * hi;
    __builtin_amdgcn_sched_barrier(0);
    o0 = MFMA32(vfrag(v0), p00, o0); o0 = MFMA32(vfrag(v0 + 16), p01, o0); o0 = MFMA32(vfrag(v0 + 32), p10, o0); o0 = MFMA32(vfrag(v0 + 48), p11, o0);
    __builtin_amdgcn_sched_barrier(0);
    o1 = MFMA32(vfrag(v1), p00, o1); o1 = MFMA32(vfrag(v1 + 16), p01, o1); o1 = MFMA32(vfrag(v1 + 32), p10, o1); o1 = MFMA32(vfrag(v1 + 48), p11, o1);
    __builtin_amdgcn_sched_barrier(0);
}
typedef short v4i16_t __attribute__((ext_vector_type(4)));
DI bf16x8 vfrag_tr(const LAS bf16* p) {
    const s16x4 lo = __builtin_bit_cast(s16x4, __builtin_amdgcn_ds_read_tr16_b64_v4i16((LAS v4i16_t*)p));
    const s16x4 hi = __builtin_bit_cast(s16x4, __builtin_amdgcn_ds_read_tr16_b64_v4i16((LAS v4i16_t*)(p + 8 * KP)));
    return __builtin_shufflevector(lo, hi, 0, 1, 2, 3, 4, 5, 6, 7);
}
DI void pv_tile_tr(f32x16& o0, f32x16& o1, const bf16x8 p00, const bf16x8 p01, const bf16x8 p10, const bf16x8 p11, const LAS bf16* Vr, int lane) {
    const int i16 = lane & 15; const LAS bf16* b0 = Vr + (4 * (lane >> 5) + (i16 >> 2)) * KP + 16 * ((lane >> 4) & 1) + 4 * (i16 & 3);
    __builtin_amdgcn_sched_barrier(0);
    o0 = MFMA32(vfrag_tr(b0), p00, o0); o0 = MFMA32(vfrag_tr(b0 + 16 * KP), p01, o0); o0 = MFMA32(vfrag_tr(b0 + 32 * KP), p10, o0); o0 = MFMA32(vfrag_tr(b0 + 48 * KP), p11, o0);
    __builtin_amdgcn_sched_barrier(0);
    o1 = MFMA32(vfrag_tr(b0 + 32), p00, o1); o1 = MFMA32(vfrag_tr(b0 + 32 + 16 * KP), p01, o1); o1 = MFMA32(vfrag_tr(b0 + 32 + 32 * KP), p10, o1); o1 = MFMA32(vfrag_tr(b0 + 32 + 48 * KP), p11, o1);
    __builtin_amdgcn_sched_barrier(0);
}
struct MaskNone { DI bool operator()(int) const { return true; } };
struct MaskLe { int lim; DI bool operator()(int cr) const { return cr <= lim; } };
struct MaskWin { int lim; DI bool operator()(int cr) const { return cr <= lim && cr > lim - 512; } };
template <class M>
DI void softmax_tile(f32x16& s0, f32x16& s1, float& m, float& l, float& alpha, const M& mk, bf16x8& p00, bf16x8& p01, bf16x8& p10, bf16x8& p11, bool lane_on = true) {
    float tm = -1e30f;
#pragma unroll
    for (int r = 0; r < 16; ++r) { tm = fmaxf(tm, mk(CR(r)) ? s0[r] : -1e30f); tm = fmaxf(tm, mk(CR(r) + 32) ? s1[r] : -1e30f); }
    tm = fmaxf(tm, shx(tm, 32));
    if (!lane_on) tm = -1e30f;
    const float mn = fmaxf(m, tm);
    alpha = ex2(m - mn);
    const float sub = lane_on ? mn : 1e30f;
    float ls = 0.f;
    __builtin_amdgcn_sched_barrier(0);
#pragma unroll
    for (int r = 0; r < 16; ++r) { const float p = mk(CR(r)) ? ex2(s0[r] - sub) : 0.f; ls += p; s0[r] = p; }
    p00 = pack8(s0, 0); p01 = pack8(s0, 1);
    __builtin_amdgcn_sched_barrier(0);
#pragma unroll
    for (int r = 0; r < 16; ++r) { const float p = mk(CR(r) + 32) ? ex2(s1[r] - sub) : 0.f; ls += p; s1[r] = p; }
    p10 = pack8(s1, 0); p11 = pack8(s1, 1);
    ls += shx(ls, 32);
    l = l * alpha + ls; m = mn;
    __builtin_amdgcn_sched_barrier(0);
}
#define RESCALE(o0_, o1_, al_) do { if (!__all((al_) == 1.f)) { _Pragma("unroll") for (int i_ = 0; i_ < 16; ++i_) { o0_[i_] *= (al_); o1_[i_] *= (al_); } } } while (0)
DI u32x4 ldk16(const bf16* src, int pitch, int tid) { return *(const u32x4*)(src + (size_t)(tid >> 3) * pitch + (tid & 7) * 8); }
DI void stk16(LAS bf16* Kt, u32x4 v, int tid) { *(LAS u32x4*)(Kt + (tid >> 3) * KP + (tid & 7) * 8) = v; }
DI u32x4 ldv16(const bf16* src, int pitch, int tid) { return *(const u32x4*)(src + (size_t)(tid & 63) * pitch + (tid >> 6) * 8); }
DI void stvt(LAS bf16* Vt, u32x4 v, int tid) {
    const int key = tid & 63, d0 = (tid >> 6) * 8; LAS bf16* p = Vt + d0 * VP + key;
    p[0] = (bf16)(v.x & 0xffffu); p[VP] = (bf16)(v.x >> 16); p[2 * VP] = (bf16)(v.y & 0xffffu); p[3 * VP] = (bf16)(v.y >> 16);
    p[4 * VP] = (bf16)(v.z & 0xffffu); p[5 * VP] = (bf16)(v.z >> 16); p[6 * VP] = (bf16)(v.w & 0xffffu); p[7 * VP] = (bf16)(v.w >> 16);
}

#define SBAR() __builtin_amdgcn_sched_barrier(0)
#define PINV(x) asm volatile("" : "+v"(x))
constexpr float ATHR = 8.f;
constexpr int RING_BYTES = 4 * KT_BYTES;
DI float pel(const f32x16& a, const f32x16& b, int i) { return i < 16 ? a[i] : b[i - 16]; }
DI float bf16r(float x) { return bflo(pk2(x, x)); }
DI float rowmax_local(const f32x16& p0, const f32x16& p1) {
    float a = fmaxf(fmaxf(p0[0], p0[1]), p1[0]), b = fmaxf(fmaxf(p0[2], p0[3]), p1[1]); a = fmaxf(fmaxf(a, p1[2]), p1[3]);
#pragma unroll
    for (int r = 4; r < 16; r += 4) { a = fmaxf(fmaxf(a, p0[r]), p0[r + 1]); b = fmaxf(fmaxf(b, p0[r + 2]), p0[r + 3]); a = fmaxf(fmaxf(a, p1[r]), p1[r + 1]); b = fmaxf(fmaxf(b, p1[r + 2]), p1[r + 3]); }
    return fmaxf(a, b);
}
DI float xhalf_max(float x) { return fmaxf(x, shx(x, 32)); }
DI float xhalf_sum(float x) { return x + shx(x, 32); }
DI float rowmax32(const f32x16& p0, const f32x16& p1) { return xhalf_max(rowmax_local(p0, p1)); }
DI unsigned cvtpk_pin(float lo, float hi) { unsigned r; asm volatile("v_cvt_pk_bf16_f32 %0, %1, %2" : "=v"(r) : "v"(lo), "v"(hi)); return r; }
DI u32x4 ldg16(const bf16* base, unsigned boff) { return *(const u32x4*)((const char*)base + boff); }
#define AS_VRD(vp, i) vf[i] = vfrag_tr((vp) + 32 * ((i) >> 2) + 16 * KP * ((i) & 3))
#define AS_KPAIR(kp, d) do { kf[2 * ((d) & 1)] = *(const LAS bf16x8*)((kp) + 16 * (d)); kf[2 * ((d) & 1) + 1] = *(const LAS bf16x8*)((kp) + 32 * KP + 16 * (d)); } while (0)
#define AS_QX(t) do { u32x4 q_; q_.x = (__builtin_bit_cast(unsigned, -mref) >> 16) | (rowoff(t) << 16); q_.y = 0u; q_.z = 0u; q_.w = 0u; qx = __builtin_bit_cast(bf16x8, q_); } while (0)
#define AS_PACK(P0, P1, i) do { pwd[2 * (i)] = cvtpk_pin(pel(P0, P1, 4 * (i)), pel(P0, P1, 4 * (i) + 1)); pwd[2 * (i) + 1] = cvtpk_pin(pel(P0, P1, 4 * (i) + 2), pel(P0, P1, 4 * (i) + 3)); } while (0)
#define AS_PW(k) __builtin_bit_cast(bf16x8, (u32x4){pwd[4 * (k)], pwd[4 * (k) + 1], pwd[4 * (k) + 2], pwd[4 * (k) + 3]})
#define AS_PHASEA(C0, C1, P0, P1, vp, kp) do { float sacc = P0[0] + P0[1]; AS_KPAIR(kp, 0); \
    _Pragma("unroll") for (int j = 0; j < NQ; ++j) { \
        const int c0 = (NQ >= 8) ? (j < 8 ? j : 8) : (j < 4 ? j : 4 + 2 * (j - 4)); \
        const int c1 = (NQ >= 8) ? (j + 1 < 8 ? j + 1 : 8) : (j + 1 < 4 ? j + 1 : 4 + 2 * (j + 1 - 4)); \
        if (j >= 2 && (j & 1) == 0 && (j >> 1) < NKS) AS_KPAIR(kp, j >> 1); \
        _Pragma("unroll") for (int i = c0; i < c1; ++i) if (i >= 4) AS_VRD(vp, i - 4); \
        SBAR(); \
        if (j == 0) C0 = MFMA32(kx, qx, zero16); else if (j == 1) C1 = MFMA32(kx, qx, zero16); \
        else if ((j & 1) == 0) C0 = MFMA32(kf[2 * (((j - 2) >> 1) & 1)], qf[(j - 2) >> 1], C0); else C1 = MFMA32(kf[2 * (((j - 2) >> 1) & 1) + 1], qf[(j - 2) >> 1], C1); \
        _Pragma("unroll") for (int i = c0; i < c1; ++i) { \
            _Pragma("unroll") for (int e = 2 + 4 * i; e < 6 + 4 * i; ++e) if (e < 32) sacc += pel(P0, P1, e); \
            AS_PACK(P0, P1, i); } \
        PINV(sacc); SBAR(); } \
    l += sacc; } while (0)
#define AS_EXP4(C0, C1, e) do { if ((e) < 16) C0[(e) & 15] = ex2(C0[(e) & 15]); else if ((e) < 32) C1[(e) & 15] = ex2(C1[(e) & 15]); } while (0)
#define AS_PHASEB(C0, C1, vp, t) do { maskfn(t, C0, C1); \
    const float rml = rowmax_local(C0, C1); const float rmo = shx(rml, 32); \
    AS_VRD(vp, 4); AS_VRD(vp, 5); SBAR(); \
    o0 = MFMA32(vf[0], AS_PW(0), o0); SBAR(); \
    o0 = MFMA32(vf[1], AS_PW(1), o0); \
    const float rm = fmaxf(rml, rmo); moved = false; SBAR(); \
    if (__any(rm > ATHR)) { const float dl = fmaxf(rm, 0.f); const float mn = bf16r(mref + dl); const float dle = mn - mref; mref = mn; fres = ex2(-dle); l *= fres; \
        _Pragma("unroll") for (int r = 0; r < 16; ++r) { C0[r] -= dle; C1[r] -= dle; } moved = true; mhook(t, fres); } \
    SBAR(); \
    _Pragma("unroll") for (int g = 2; g < 8; ++g) { \
        if (g < 4) { AS_VRD(vp, 4 + g); SBAR(); } \
        if (g < 4) o0 = MFMA32(vf[g], AS_PW(g), o0); else o1 = MFMA32(vf[g], AS_PW(g - 4), o1); \
        _Pragma("unroll") for (int e = ((g - 2) * 16 + 2) / 3; e < ((g - 1) * 16 + 2) / 3; ++e) AS_EXP4(C0, C1, e); \
        PINV(C0); PINV(C1); \
        SBAR(); } \
    if (moved) { _Pragma("unroll") for (int r = 0; r < 16; ++r) { o0[r] *= fres; o1[r] *= fres; } } } while (0)
#define AS_STEP(C0, C1, P0, P1, t) do { \
    const LAS bf16* vp_ = ringe + (2 + (((t) - 1) & 1)) * SLOT + vfo; const LAS bf16* kp_ = ringe + ((t) & 1) * SLOT + kfo; \
    AS_QX(t); SBAR(); AS_PHASEA(C0, C1, P0, P1, vp_, kp_); phook((t) - 1, P0, P1); AS_PHASEB(C0, C1, vp_, t); } while (0)
#define AS_DRAIN(P0, P1, tl) do { const LAS bf16* vp_ = ringe + (2 + ((tl) & 1)) * SLOT + vfo; phook(tl, P0, P1); \
    _Pragma("unroll") for (int i = 0; i < 8; ++i) AS_VRD(vp_, i); \
    float sacc = 0.f; _Pragma("unroll") for (int e = 0; e < 32; ++e) sacc += pel(P0, P1, e); l += sacc; \
    _Pragma("unroll") for (int i = 0; i < 8; ++i) AS_PACK(P0, P1, i); \
    _Pragma("unroll") for (int g = 0; g < 8; ++g) { if (g < 4) o0 = MFMA32(vf[g], AS_PW(g), o0); else o1 = MFMA32(vf[g], AS_PW(g - 4), o1); } \
    SBAR(); } while (0)
#define AS_STAGE(t) do { *(LAS u32x4*)(ringe + (((t) + 1) & 1) * SLOT + sto) = kreg; *(LAS u32x4*)(ringe + (2 + ((t) & 1)) * SLOT + sto) = vreg; \
    kreg = ldg16(ksrc(((t) + 2 < NT) ? (t) + 2 : NT - 1), goff); vreg = ldg16(vsrc(((t) + 1 < NT) ? (t) + 1 : NT - 1), goff); } while (0)
template <int NKS, class KS, class VS, class MF, class RO, class PH, class MH>
DI void attn_stream(f32x16& o0, f32x16& o1, float& lsum, LAS unsigned char* ring, const bf16x8* qf, const int koff, const int NT, const int NTw,
                    const KS ksrc, const VS vsrc, const int pitch, const MF maskfn, const RO rowoff, const PH phook, const MH mhook, const int tid) {
    const int lane = tid & 63, r32 = lane & 31, hi = lane >> 5, i16 = lane & 15;
    LAS bf16* const ringe = (LAS bf16*)ring;
    constexpr int SLOT = 64 * KP, NQ = 2 * NKS + 2;
    const int kfo = r32 * KP + koff + 8 * hi;
    const int vfo = (4 * hi + (i16 >> 2)) * KP + 16 * ((lane >> 4) & 1) + 4 * (i16 & 3);
    const int sto = (tid >> 3) * KP + (tid & 7) * 8;
    const unsigned goff = (unsigned)(((tid >> 3) * pitch + (tid & 7) * 8) * 2);
    bf16x8 kx; { u32x4 t_; t_.x = hi ? 0u : 0x3F803F80u; t_.y = 0u; t_.z = 0u; t_.w = 0u; kx = __builtin_bit_cast(bf16x8, t_); }
    const f32x16 zero16 = {0.f, 0.f, 0.f, 0.f, 0.f, 0.f, 0.f, 0.f, 0.f, 0.f, 0.f, 0.f, 0.f, 0.f, 0.f, 0.f};
    f32x16 pA0, pA1, pB0, pB1; bf16x8 kf[4], vf[8], qx; unsigned pwd[16];
    float l = 0.f, mref = 0.f, fres = 1.f; bool moved = false;
#pragma unroll
    for (int i = 0; i < 16; ++i) { o0[i] = 0.f; o1[i] = 0.f; }
    u32x4 kreg, vreg;
    {
        const u32x4 k0 = ldg16(ksrc(0), goff), k1 = ldg16(ksrc(NT > 1 ? 1 : 0), goff), v0 = ldg16(vsrc(0), goff);
        kreg = ldg16(ksrc(NT > 2 ? 2 : NT - 1), goff); vreg = ldg16(vsrc(NT > 1 ? 1 : 0), goff);
        *(LAS u32x4*)(ringe + sto) = k0; *(LAS u32x4*)(ringe + SLOT + sto) = k1; *(LAS u32x4*)(ringe + 2 * SLOT + sto) = v0;
    }
    __syncthreads();
    {
        AS_QX(0);
        pA0 = MFMA32(kx, qx, zero16); pA1 = MFMA32(kx, qx, zero16);
#pragma unroll
        for (int d = 0; d < NKS; ++d) { const bf16x8 a0 = *(const LAS bf16x8*)(ringe + kfo + 16 * d), a1 = *(const LAS bf16x8*)(ringe + kfo + 32 * KP + 16 * d); pA0 = MFMA32(a0, qf[d], pA0); pA1 = MFMA32(a1, qf[d], pA1); }
        maskfn(0, pA0, pA1);
        mref = bf16r(fmaxf(rowmax32(pA0, pA1), -1e4f));
#pragma unroll
        for (int r = 0; r < 16; ++r) { pA0[r] = ex2(pA0[r] - mref); pA1[r] = ex2(pA1[r] - mref); }
    }
    __syncthreads();
    int t = 1;
#pragma unroll 1
    for (; t + 1 < NTw; t += 2) {
        AS_STAGE(t); AS_STEP(pB0, pB1, pA0, pA1, t); __syncthreads();
        AS_STAGE(t + 1); AS_STEP(pA0, pA1, pB0, pB1, t + 1); __syncthreads();
    }
    if (t < NTw) { AS_STAGE(t); AS_STEP(pB0, pB1, pA0, pA1, t); __syncthreads(); AS_DRAIN(pB0, pB1, t); ++t; }
    else AS_DRAIN(pA0, pA1, t - 1);
#pragma unroll 1
    for (; t < NT; ++t) { AS_STAGE(t); __syncthreads(); }
    lsum = xhalf_sum(l);
    __syncthreads();
}

DI void nsa_item(const Ctx& c, int b, int tb) {
    LAS bf16* Kt0 = (LAS bf16*)(c.lds); LAS bf16* Kt1 = (LAS bf16*)(c.lds + KT_BYTES);
    LAS bf16* Vt0 = (LAS bf16*)(c.lds + 2 * KT_BYTES); LAS bf16* Vt1 = (LAS bf16*)(c.lds + 3 * KT_BYTES);
    LAS float* imph = (LAS float*)(c.lds + RING_BYTES);
    LAS float* accL = (LAS float*)(c.lds + RING_BYTES);
    LAS float* facs = (LAS float*)(c.lds + RING_BYTES + 8 * 32 * 64 * 4 + 512);
    LAS unsigned* selm = (LAS unsigned*)(c.lds + RING_BYTES + 8 * 32 * 64 * 4);
    int tid = c.tid; asm volatile("" : "+v"(tid)); const int lane = tid & 63, w = __builtin_amdgcn_readfirstlane(tid >> 6), r32 = lane & 31, hi = lane >> 5;
    const int tokl = 8 * w + (r32 >> 2), head = r32 & 3;
    const int row = b * SEQ + 64 * tb + tokl, pos = 64 * tb + tokl;
    const bf16* proj = c.wsb(WS_PROJ); const bf16* prow = proj + (size_t)row * PC;
    const bf16* pb = proj + (size_t)b * SEQ * PC;
    bf16x8 qf[4];
#pragma unroll
    for (int s = 0; s < 4; ++s) qf[s] = *(const bf16x8*)(prow + A_Q + head * 64 + 16 * s + 8 * hi);
    const float g_c = sigm(bf2f(prow[SMC + head * 3 + 0])), g_s = sigm(bf2f(prow[SMC + head * 3 + 1])), g_w = sigm(bf2f(prow[SMC + head * 3 + 2]));
    f32x16 acc0, acc1;
#pragma unroll
    for (int i = 0; i < 16; ++i) { acc0[i] = 0.f; acc1[i] = 0.f; }
    __syncthreads();
    const int ncmp = 4 * tb + 3; const int ntc = (ncmp + 63) >> 6;
    const bf16* kcn = c.wsb(WS_KCN) + (size_t)b * 256 * 64; const bf16* vcn = c.wsb(WS_VCN) + (size_t)b * 256 * 64;
    const int klim = (pos - 31) >> 4;
    {
        f32x16 o0, o1; float l;
        LAS float* rowp = imph + (32 * w + r32) * 64; float carry = 0.f;
        attn_stream<4>(o0, o1, l, c.lds, qf, 0, ntc, ntc,
            [&](int t) { return kcn + (size_t)(64 * t) * 64; }, [&](int t) { return vcn + (size_t)(64 * t) * 64; }, 64,
            [&](int t, f32x16& C0, f32x16& C1) { if (64 * t + 63 > 4 * tb - 2) { const int lim = klim - (64 * t + 4 * hi);
#pragma unroll
                for (int r = 0; r < 16; ++r) { if (CR(r) > lim) C0[r] = -__builtin_inff(); if (CR(r) + 32 > lim) C1[r] = -__builtin_inff(); } } },
            [&](int) { return 0u; },
            [&](int tp, const f32x16& P0, const f32x16& P1) {
#pragma unroll
                for (int kb = 0; kb < 2; ++kb)
#pragma unroll
                    for (int q4 = 0; q4 < 4; ++q4) { const float p0 = kb ? P1[4 * q4] : P0[4 * q4], p1 = kb ? P1[4 * q4 + 1] : P0[4 * q4 + 1], p2 = kb ? P1[4 * q4 + 2] : P0[4 * q4 + 2], p3 = kb ? P1[4 * q4 + 3] : P0[4 * q4 + 3];
                        const float x = shx(p3, 32);
                        const float spill = hi ? x : carry;
                        rowp[16 * tp + 8 * kb + 2 * q4 + hi] = 2.f * (p0 + p1 + p2) + p3 + spill;
                        carry = x; } },
            [&](int t, float f) { carry *= f; for (int j = hi; j < 16 * t && j < 64; j += 2) rowp[j] *= f; },
            tid);
        const float inv = l > 0.f ? 1.f / l : 0.f;
        if (hi == 0) facs[32 * w + r32] = inv;
        const float sc = g_c * inv;
#pragma unroll
        for (int i = 0; i < 16; ++i) { acc0[i] = sc * o0[i]; acc1[i] = sc * o1[i]; }
    }
    __syncthreads();
    {   const int j = lane; const bool valid = j <= tb;
        if (tb < 16) { const unsigned long long msk = __ballot(valid);
            if (lane == 0) {
#pragma unroll
                for (int tk = 0; tk < 8; ++tk) { selm[2 * (8 * w + tk)] = (unsigned)msk; selm[2 * (8 * w + tk) + 1] = (unsigned)(msk >> 32); } } }
        else {
            const bool forced = (j == 0) || (j == tb) || (j == tb - 1);
            unsigned key[8], T[8];
#pragma unroll
            for (int tk = 0; tk < 8; ++tk) { const int tl = 8 * w + tk; float imp = 0.f;
#pragma unroll
                for (int hh = 0; hh < 4; ++hh) imp += facs[tl * 4 + hh] * imph[(tl * 4 + hh) * 64 + j];
                key[tk] = valid ? __builtin_bit_cast(unsigned, imp + (forced ? 1000.f : 0.f)) + 1u : 0u; T[tk] = 0u; }
#pragma unroll 1
            for (int bit = 31; bit >= 0; --bit) {
#pragma unroll
                for (int tk = 0; tk < 8; ++tk) { const unsigned cand = T[tk] | (1u << bit); if (__popcll(__ballot(key[tk] >= cand)) >= 16) T[tk] = cand; } }
#pragma unroll
            for (int tk = 0; tk < 8; ++tk) {
                const unsigned long long gt = __ballot(key[tk] > T[tk]); unsigned long long eq = __ballot(key[tk] == T[tk]), pick = 0ull;
                const int need = 16 - __popcll(gt);
                for (int q = 0; q < need; ++q) { const unsigned long long low = eq & (~eq + 1ull); pick |= low; eq ^= low; }
                const unsigned long long msk = gt | pick;
                if (lane == 0) { selm[2 * (8 * w + tk)] = (unsigned)msk; selm[2 * (8 * w + tk) + 1] = (unsigned)(msk >> 32); } }
        }
    }
    __syncthreads();
    const unsigned long long mymask = (unsigned long long)selm[2 * tokl] | ((unsigned long long)selm[2 * tokl + 1] << 32);
    LAS float* accl = accL + (w * 32) * 64 + lane;
#pragma unroll
    for (int i = 0; i < 16; ++i) { accl[i * 64] = acc0[i]; accl[(16 + i) * 64] = acc1[i]; }
    {
        f32x16 o0, o1; float l;
        const bf16* kb = pb + A_KS; const bf16* vb = pb + A_VS;
        attn_stream<4>(o0, o1, l, c.lds, qf, 0, tb + 1, tb + 1,
            [&](int t) { return kb + (size_t)(64 * t) * PC; }, [&](int t) { return vb + (size_t)(64 * t) * PC; }, PC,
            [&](int t, f32x16& C0, f32x16& C1) { if (t == tb) { const int lim = pos - (64 * t + 4 * hi);
#pragma unroll
                for (int r = 0; r < 16; ++r) { if (CR(r) > lim) C0[r] = -__builtin_inff(); if (CR(r) + 32 > lim) C1[r] = -__builtin_inff(); } } },
            [&](int t) { return ((mymask >> t) & 1ull) ? 0u : 0xFF7Fu; }, [&](int, const f32x16&, const f32x16&) {}, [&](int, float) {}, tid);
        const float sc = l > 0.f ? g_s / l : 0.f;
#pragma unroll
        for (int i = 0; i < 16; ++i) { accl[i * 64] += sc * o0[i]; accl[(16 + i) * 64] += sc * o1[i]; }
    }
    {
        f32x16 o0, o1; float l;
        const int j0 = tb >= 8 ? tb - 8 : 0; const int wminpos = 64 * tb + 8 * w;
        const bf16* kb = pb + (size_t)(64 * j0) * PC + A_KW; const bf16* vb = pb + (size_t)(64 * j0) * PC + A_VW;
        attn_stream<4>(o0, o1, l, c.lds, qf, 0, tb - j0 + 1, tb - j0 + 1,
            [&](int t) { return kb + (size_t)(64 * t) * PC; }, [&](int t) { return vb + (size_t)(64 * t) * PC; }, PC,
            [&](int t, f32x16& C0, f32x16& C1) { const int kt0 = 64 * (j0 + t);
                if (!(kt0 + 63 <= wminpos && kt0 >= wminpos + 7 - 511)) { const int lim = pos - (kt0 + 4 * hi);
#pragma unroll
                    for (int r = 0; r < 16; ++r) { if (!(CR(r) <= lim && CR(r) > lim - 512)) C0[r] = -__builtin_inff(); if (!(CR(r) + 32 <= lim && CR(r) + 32 > lim - 512)) C1[r] = -__builtin_inff(); } } },
            [&](int) { return 0u; }, [&](int, const f32x16&, const f32x16&) {}, [&](int, float) {}, tid);
        const float sc = l > 0.f ? g_w / l : 0.f;
#pragma unroll
        for (int i = 0; i < 16; ++i) { acc0[i] = accl[i * 64] + sc * o0[i]; acc1[i] = accl[(16 + i) * 64] + sc * o1[i]; }
    }
    bf16* y = c.wsb(WS_HN) + (size_t)row * DM + head * 64;
#pragma unroll
    for (int q = 0; q < 4; ++q) { const int d = 8 * q + 4 * hi;
        u32x2 w0; w0.x = pk2(acc0[4 * q], acc0[4 * q + 1]); w0.y = pk2(acc0[4 * q + 2], acc0[4 * q + 3]); *(u32x2*)(y + d) = w0;
        u32x2 w1; w1.x = pk2(acc1[4 * q], acc1[4 * q + 1]); w1.y = pk2(acc1[4 * q + 2], acc1[4 * q + 3]); *(u32x2*)(y + 32 + d) = w1; }
}

DI void diff_item(const Ctx& c, int b, int h, int qt, float lam_full, float lam_init) {
    int tid = c.tid; asm volatile("" : "+v"(tid)); const int lane = tid & 63, w = __builtin_amdgcn_readfirstlane(tid >> 6), r32 = lane & 31, hi = lane >> 5;
    const int st = w >> 2, w4 = w & 3;
    const int pos = 128 * qt + 32 * w4 + r32, row = b * SEQ + pos;
    const bf16* proj = c.wsb(WS_PROJ); const bf16* prow = proj + (size_t)row * PC; const bf16* pb = proj + (size_t)b * SEQ * PC;
    bf16x8 qf[2];
#pragma unroll
    for (int s = 0; s < 2; ++s) qf[s] = *(const bf16x8*)(prow + D_Q + h * 64 + 32 * st + 16 * s + 8 * hi);
    const int NT = 2 * qt + 2, NTw = 2 * qt + (w4 >> 1) + 1;
    f32x16 o0, o1; float l;
    const bf16* kb = pb + D_K + h * 64; const bf16* vb = pb + D_V + h * 64;
    attn_stream<2>(o0, o1, l, c.lds, qf, 32 * st, NT, NTw,
        [&](int t) { return kb + (size_t)(64 * t) * PC; }, [&](int t) { return vb + (size_t)(64 * t) * PC; }, PC,
        [&](int t, f32x16& C0, f32x16& C1) { if (t == NTw - 1) { const int lim = pos - (64 * t + 4 * hi);
#pragma unroll
            for (int r = 0; r < 16; ++r) { if (CR(r) > lim) C0[r] = -__builtin_inff(); if (CR(r) + 32 > lim) C1[r] = -__builtin_inff(); } } },
        [&](int) { return 0u; }, [&](int, const f32x16&, const f32x16&) {}, [&](int, float) {}, tid);
    LAS float* X = (LAS float*)c.lds + (w4 * 32) * 64 + lane;
    if (st == 1) { const float ib = lam_full / l;
#pragma unroll
        for (int i = 0; i < 16; ++i) { X[i * 64] = o0[i] * ib; X[(16 + i) * 64] = o1[i] * ib; } }
    const float* ng = c.in[18] + (size_t)c.l * 64;
    f32x4 gq0[4], gq1[4];
#pragma unroll
    for (int q = 0; q < 4; ++q) { gq0[q] = *(const f32x4*)(ng + 8 * q + 4 * hi); gq1[q] = *(const f32x4*)(ng + 32 + 8 * q + 4 * hi); }
    __syncthreads();
    if (st == 0) {
        const float ia = 1.f / l; float ss = 0.f;
#pragma unroll
        for (int i = 0; i < 16; ++i) { o0[i] = o0[i] * ia - X[i * 64]; o1[i] = o1[i] * ia - X[(16 + i) * 64]; ss += o0[i] * o0[i] + o1[i] * o1[i]; }
        ss += shx(ss, 32);
        const float rs = rsq(ss * (1.f / 64) + EPS) * (1.f - lam_init);
        bf16* y = c.wsb(WS_HN) + (size_t)row * DM + 768 + h * 64;
#pragma unroll
        for (int q = 0; q < 4; ++q) { const int d = 8 * q + 4 * hi; const f32x4 g0 = gq0[q], g1 = gq1[q];
            u32x2 w0; w0.x = pk2(o0[4 * q] * rs * g0[0], o0[4 * q + 1] * rs * g0[1]); w0.y = pk2(o0[4 * q + 2] * rs * g0[2], o0[4 * q + 3] * rs * g0[3]); *(u32x2*)(y + d) = w0;
            u32x2 w1; w1.x = pk2(o1[4 * q] * rs * g1[0], o1[4 * q + 1] * rs * g1[1]); w1.y = pk2(o1[4 * q + 2] * rs * g1[2], o1[4 * q + 3] * rs * g1[3]); *(u32x2*)(y + 32 + d) = w1; }
    }
    __syncthreads();
}

DI void xattn_item(const Ctx& c, int b, int h, int qt) {
    LAS bf16* Kt0 = (LAS bf16*)(c.lds); LAS bf16* Kt1 = (LAS bf16*)(c.lds + KT_BYTES);
    LAS bf16* Vt0 = (LAS bf16*)(c.lds + 2 * KT_BYTES); LAS bf16* Vt1 = (LAS bf16*)(c.lds + 3 * KT_BYTES);
    int tid = c.tid; asm volatile("" : "+v"(tid)); const int lane = tid & 63, w = __builtin_amdgcn_readfirstlane(tid >> 6), r32 = lane & 31, hi = lane >> 5;
    const int row = b * SEQ + 256 * qt + 32 * w + r32;
    const float* gq = c.in[23] + (size_t)c.l * 128; const float* gk = gq + 64;
    const bf16* xq = c.wsb(WS_XQ) + (size_t)row * 256 + h * 64; const bf16* xkv = c.wsb(WS_XKV) + (size_t)b * 256 * 512;
    u32x4 xqr[4], kr[4], vr[4]; f32x4 gqr[4][2];
#pragma unroll
    for (int s = 0; s < 4; ++s) xqr[s] = *(const u32x4*)(xq + 16 * s + 8 * hi);
#pragma unroll
    for (int it = 0; it < 4; ++it) { kr[it] = ldk16(xkv + (size_t)(64 * it) * 512 + h * 64, 512, tid); vr[it] = ldk16(xkv + (size_t)(64 * it) * 512 + 256 + h * 64, 512, tid); }
#pragma unroll
    for (int s = 0; s < 4; ++s) { gqr[s][0] = *(const f32x4*)(gq + 16 * s + 8 * hi); gqr[s][1] = *(const f32x4*)(gq + 16 * s + 8 * hi + 4); }
    const f32x4 gk0 = *(const f32x4*)(gk + (tid & 7) * 8), gk1 = *(const f32x4*)(gk + (tid & 7) * 8 + 4);
    bf16x8 qf[4];
    { float x[4][8]; float ss = 0.f;
#pragma unroll
        for (int s = 0; s < 4; ++s) { const u32x4 v = xqr[s];
            x[s][0] = bflo(v.x); x[s][1] = bfhi(v.x); x[s][2] = bflo(v.y); x[s][3] = bfhi(v.y); x[s][4] = bflo(v.z); x[s][5] = bfhi(v.z); x[s][6] = bflo(v.w); x[s][7] = bfhi(v.w);
#pragma unroll
            for (int i = 0; i < 8; ++i) ss += x[s][i] * x[s][i]; }
        ss += shx(ss, 32);
        const float rs = rsq(ss * (1.f / 64) + EPS) * QSCALE;
#pragma unroll
        for (int s = 0; s < 4; ++s) { float y[8];
#pragma unroll
            for (int i = 0; i < 8; ++i) y[i] = x[s][i] * rs * gqr[s][i >> 2][i & 3];
            qf[s] = __builtin_bit_cast(bf16x8, f8_to_bf(y)); } }
    f32x16 o0, o1;
#pragma unroll
    for (int i = 0; i < 16; ++i) { o0[i] = 0.f; o1[i] = 0.f; }
    float m = -1e30f, l = 0.f;
#pragma unroll
    for (int it = 0; it < 4; ++it) {
        LAS bf16* Kt = (it & 1) ? Kt1 : Kt0; LAS bf16* Vt = (it & 1) ? Vt1 : Vt0;
        {
            const u32x4 kreg = kr[it];
            float x[8] = {bflo(kreg.x), bfhi(kreg.x), bflo(kreg.y), bfhi(kreg.y), bflo(kreg.z), bfhi(kreg.z), bflo(kreg.w), bfhi(kreg.w)}; float ss = 0.f;
#pragma unroll
            for (int i = 0; i < 8; ++i) ss += x[i] * x[i];
            ss += shx(ss, 1); ss += shx(ss, 2); ss += shx(ss, 4);
            const float rs = rsq(ss * (1.f / 64) + EPS); const int ch = tid & 7;
#pragma unroll
            for (int i = 0; i < 8; ++i) x[i] = x[i] * rs * (i < 4 ? gk0[i & 3] : gk1[i & 3]);
            stk16(Kt, f8_to_bf(x), tid); }
        stk16(Vt, vr[it], tid);
        __syncthreads();
        f32x16 s0, s1; float al; bf16x8 q0, q1, q2, q3; qk_tile<4>(s0, s1, Kt, 0, qf, r32, hi);
        softmax_tile(s0, s1, m, l, al, MaskNone{}, q0, q1, q2, q3);
        RESCALE(o0, o1, al);
        pv_tile_tr(o0, o1, q0, q1, q2, q3, Vt, lane);
    }
    __syncthreads();
    const float inv = 1.f / l;
    bf16* y = c.wsb(WS_XAO) + (size_t)row * 256 + h * 64;
#pragma unroll
    for (int q = 0; q < 4; ++q) { const int d = 8 * q + 4 * hi;
        u32x2 w0; w0.x = pk2(o0[4 * q] * inv, o0[4 * q + 1] * inv); w0.y = pk2(o0[4 * q + 2] * inv, o0[4 * q + 3] * inv); *(u32x2*)(y + d) = w0;
        u32x2 w1; w1.x = pk2(o1[4 * q] * inv, o1[4 * q + 1] * inv); w1.y = pk2(o1[4 * q + 2] * inv, o1[4 * q + 3] * inv); *(u32x2*)(y + 32 + d) = w1; }
}

DI void gdn_raw_load(const Ctx& c, int item, int tid, u32x4 (&rv)[4]) {
    const int n = item & 63, h = (item >> 6) & 3, b = item >> 8; const bf16* proj = c.wsb(WS_PROJ);
#pragma unroll
    for (int i = 0; i < 4; ++i) { const int e = tid + 512 * i; const int r = e / 24, rem = e % 24, seg = rem >> 3, c8 = rem & 7; const int tk = n * 64 + r - 3;
        const int col = (seg == 0 ? B_Q : (seg == 1 ? B_K : B_V)) + 64 * h + 8 * c8;
        rv[i] = (e < 67 * 24 && tk >= 0) ? __builtin_nontemporal_load((const u32x4*)(proj + (size_t)(b * SEQ + tk) * PC + col)) : (u32x4){0u, 0u, 0u, 0u}; }
}
DI void gdn_prep_item(const Ctx& c, int item, int item_next, u32x4 (&rv)[4]) {
    const int n = item & 63, h = (item >> 6) & 3, b = item >> 8; int tid = c.tid; asm volatile("" : "+v"(tid));
    LAS float* raw = (LAS float*)c.lds;
    LAS float* qs = raw + 67 * 192;
    LAS float* ks = qs + 64 * 65; LAS float* vs = ks + 64 * 65;
    LAS float* Am = vs + 64 * 65;
    LAS float* gcs = Am + 64 * 68; LAS float* betas = gcs + 64; LAS float* egc = betas + 64;
    const bf16* proj = c.wsb(WS_PROJ); const float* cw = c.in[9] + (size_t)c.l * 4 * 768;
    __syncthreads();
    float wq[4], wk[4], wv[4];
#pragma unroll
    for (int j = 0; j < 4; ++j) { wq[j] = cw[j * 768 + 64 * h + (tid & 63)]; wk[j] = cw[j * 768 + 256 + 64 * h + (tid & 63)]; wv[j] = cw[j * 768 + 512 + 64 * h + (tid & 63)]; }
    bf16 ga_raw = 0, gb_raw = 0; float gA_ = 0.f, gB_ = 0.f;
    if (tid >= 448) { const bf16* pr = proj + (size_t)(b * SEQ + n * 64 + (tid - 448)) * PC + SMC; ga_raw = pr[12 + h]; gb_raw = pr[16 + h]; gA_ = c.in[10][c.l * 4 + h]; gB_ = c.in[11][c.l * 4 + h]; }
    for (int r5_ = 0; r5_ < (REP_PH == 45 ? 2 : 1); ++r5_) {
    __syncthreads();
    {
        if (REP_PH == 45 && r5_ > 0) gdn_raw_load(c, item, tid, rv);
#pragma unroll
        for (int i = 0; i < 4; ++i) { const int e = tid + 512 * i; const int r = e / 24, rem = e % 24, seg = rem >> 3, c8 = rem & 7;
            if (e < 67 * 24) { LAS float* p = raw + r * 192 + seg * 64 + 8 * c8;
                *(LAS f32x4*)p = (f32x4){bflo(rv[i].x), bfhi(rv[i].x), bflo(rv[i].y), bfhi(rv[i].y)}; *(LAS f32x4*)(p + 4) = (f32x4){bflo(rv[i].z), bfhi(rv[i].z), bflo(rv[i].w), bfhi(rv[i].w)}; } }
    }
    {
        const int d = tid & 63, rg = tid >> 6;
        __syncthreads();
#pragma unroll
        for (int i = 0; i < 8; ++i) { const int r = rg + 8 * i; float aq = 0.f, ak = 0.f, av = 0.f;
#pragma unroll
            for (int j = 0; j < 4; ++j) { const LAS float* p = raw + (r + j) * 192 + d; aq += wq[j] * p[0]; ak += wk[j] * p[64]; av += wv[j] * p[128]; }
            qs[r * 65 + d] = silu(aq); ks[r * 65 + d] = silu(ak); vs[r * 65 + d] = silu(av); }
    }
    __syncthreads();
    {
        const int rw = tid >> 2, sub = tid & 3, r = rw & 63, which = rw >> 6; LAS float* arr = (which ? ks : qs) + r * 65 + 16 * sub; float x[16]; float ss = 0.f;
#pragma unroll
        for (int i = 0; i < 16; ++i) { x[i] = arr[i]; ss += x[i] * x[i]; }
        ss += shx(ss, 1); ss += shx(ss, 2);
        const float sc = rsq(ss + EPS) * (which ? 1.f : 0.125f);
#pragma unroll
        for (int i = 0; i < 16; ++i) { x[i] *= sc; arr[i] = x[i]; }
        LAS bf16* t16 = (LAS bf16*)raw + (which ? 0 : 64 * KP) + r * KP + 16 * sub;
        *(LAS u32x4*)t16 = (u32x4){pk2(x[0], x[1]), pk2(x[2], x[3]), pk2(x[4], x[5]), pk2(x[6], x[7])}; *(LAS u32x4*)(t16 + 8) = (u32x4){pk2(x[8], x[9]), pk2(x[10], x[11]), pk2(x[12], x[13]), pk2(x[14], x[15])};
    }
    if (tid >= 448) { const int cc = tid - 448;
        const float a = bf2f(ga_raw), bb = bf2f(gb_raw);
        float g = -fexp(gA_) * softplus_(a + gB_);
#pragma unroll
        for (int o = 1; o < 64; o <<= 1) { const float t = shu(g, o); if (cc >= o) g += t; }
        gcs[cc] = g; betas[cc] = sigm(bb); egc[cc] = fexp(g); }
    __syncthreads();
    }
    const size_t ib = (size_t)item * 4096;
    bf16* Wg = c.ob16(OUT_GW) + ib; bf16* Ug = c.ob16(OUT_GW + 16 * MiB) + ib; bf16* QDg = c.ob16(OUT_GW + 32 * MiB) + ib; bf16* KETg = c.ob16(OUT_GW + 48 * MiB) + ib; bf16* ATTg = c.ob16(OUT_GW + 64 * MiB) + ib;
    {
        const int lane = tid & 63, w = __builtin_amdgcn_readfirstlane(tid >> 6), r32 = lane & 31, hi = lane >> 5; const int isqk = w >> 2, bi = (w >> 1) & 1, bj = w & 1;
        const LAS bf16* k16 = (const LAS bf16*)raw; const LAS bf16* a16 = isqk ? k16 + 64 * KP : k16;
        f32x16 acc;
#pragma unroll
        for (int i = 0; i < 16; ++i) acc[i] = 0.f;
        if (bj <= bi) {
#pragma unroll
            for (int s4 = 0; s4 < 4; ++s4) acc = MFMA32(*(const LAS bf16x8*)(a16 + (32 * bi + r32) * KP + 16 * s4 + 8 * hi), *(const LAS bf16x8*)(k16 + (32 * bj + r32) * KP + 16 * s4 + 8 * hi), acc); }
        const int j = 32 * bj + r32; const float gj = gcs[j];
#pragma unroll
        for (int rg_ = 0; rg_ < 16; ++rg_) { const int i = 32 * bi + crow(rg_, hi); const float dec = fexp(fminf(gcs[i] - gj, 0.f));
            if (isqk) ATTg[i * 64 + j] = f2bf((j <= i) ? acc[rg_] * dec : 0.f);
            else { const float av = (j < i) ? betas[i] * acc[rg_] * dec : 0.f; Am[i * 68 + j] = av; ((LAS bf16*)raw)[2 * 64 * KP + i * KP + j] = f2bf(av); } }
    }
    { const int ty = tid >> 4, tx = tid & 15, i0 = 2 * ty, j0 = 4 * tx; const float gl = gcs[63];
#pragma unroll
        for (int a = 0; a < 2; ++a) { const int i = i0 + a; const float ei = egc[i]; float qd[4], ke[4];
#pragma unroll
            for (int q = 0; q < 4; ++q) { const int j = j0 + q; qd[q] = qs[i * 65 + j] * ei; ke[q] = ks[j * 65 + i] * fexp(gl - gcs[j]); }
            u32x2 wv; wv.x = pk2(qd[0], qd[1]); wv.y = pk2(qd[2], qd[3]); __builtin_nontemporal_store(wv, (u32x2*)(QDg + i * 64 + j0));
            wv.x = pk2(ke[0], ke[1]); wv.y = pk2(ke[2], ke[3]); __builtin_nontemporal_store(wv, (u32x2*)(KETg + i * 64 + j0)); }
        if (tid == 0) c.wsf(WS_GL)[item] = gl; }
    __syncthreads();
    if (item_next >= 0) gdn_raw_load(c, item_next, tid, rv);
    { LAS bf16* A16 = (LAS bf16*)raw + 2 * 64 * KP;
        LAS bf16* Ti16 = (LAS bf16*)raw + 3 * 64 * KP;
        LAS bf16* XT = (LAS bf16*)raw + 3 * 64 * KP + 4 * 16 * 40;
        LAS bf16* RT = (LAS bf16*)raw;
        if (tid >= 128 && tid < 192) { const int t = tid - 128, bk = t >> 4, j = t & 15; float y[16];
#pragma unroll
            for (int i = 0; i < 16; ++i) { float a0 = (i == j) ? 1.f : 0.f, a1 = 0.f;
#pragma unroll
                for (int k = 0; k < i; ++k) { const float av = Am[(16 * bk + i) * 68 + 16 * bk + k]; if (k & 1) a1 -= av * y[k]; else a0 -= av * y[k]; }
                y[i] = a0 + a1; Ti16[(bk * 16 + i) * 40 + j] = f2bf(y[i]); } }
        __syncthreads();
        const int lane = tid & 63, w = __builtin_amdgcn_readfirstlane(tid >> 6), l15 = lane & 15, g = lane >> 4; const int col = 16 * w + l15; const bool isw = w >= 4; const int cc = col & 63;
        bf16* dst = isw ? Wg : Ug; const bf16x8 zf = {0, 0, 0, 0, 0, 0, 0, 0};
#pragma unroll
        for (int bk = 0; bk < 4; ++bk) {
            f32x4 acc;
#pragma unroll
            for (int r = 0; r < 4; ++r) { const int i = 16 * bk + 4 * g + r; acc[r] = (isw ? ks[i * 65 + cc] * egc[i] : vs[i * 65 + cc]) * betas[i]; }
            if (bk > 0) { f32x4 upd = {0.f, 0.f, 0.f, 0.f};
#pragma unroll
                for (int ks_ = 0; ks_ < (16 * bk + 31) / 32; ++ks_) { const bool on = 32 * ks_ + 8 * g < 16 * bk;
                    const bf16x8 af = on ? *(const LAS bf16x8*)(A16 + (16 * bk + l15) * KP + 32 * ks_ + 8 * g) : zf;
                    const bf16x8 xf = on ? *(const LAS bf16x8*)(XT + col * KP + 32 * ks_ + 8 * g) : zf;
                    upd = __builtin_amdgcn_mfma_f32_16x16x32_bf16(af, xf, upd, 0, 0, 0); }
                acc = acc - upd; }
            { u32x2 pk; pk.x = pk2(acc[0], acc[1]); pk.y = pk2(acc[2], acc[3]); *(LAS u32x2*)(RT + col * 40 + 4 * g) = pk; }
            LDS_WAIT();
            const bf16x8 tf = (g < 2) ? *(const LAS bf16x8*)(Ti16 + (bk * 16 + l15) * 40 + 8 * g) : zf;
            const bf16x8 rf = (g < 2) ? *(const LAS bf16x8*)(RT + col * 40 + 8 * g) : zf;
            f32x4 x = {0.f, 0.f, 0.f, 0.f};
            x = __builtin_amdgcn_mfma_f32_16x16x32_bf16(tf, rf, x, 0, 0, 0);
            { u32x2 pk; pk.x = pk2(x[0], x[1]); pk.y = pk2(x[2], x[3]); *(LAS u32x2*)(XT + col * KP + 16 * bk + 4 * g) = pk; }
#pragma unroll
            for (int r = 0; r < 4; ++r) dst[(16 * bk + 4 * g + r) * 64 + cc] = f2bf(x[r]);
            LDS_WAIT();
        }
    }
}

constexpr int GT = 64 * KP * 2;
DI void gdn_scan_item(const Ctx& c, int bh, const float* gln) {
    const int b = bh >> 2, h = bh & 3; int tid = c.tid; asm volatile("" : "+v"(tid)); const int lane = tid & 63, w = __builtin_amdgcn_readfirstlane(tid >> 6), r32 = lane & 31, hi = lane >> 5;
    LAS bf16* Sb = (LAS bf16*)(c.lds + 10 * GT); LAS bf16* Vn = (LAS bf16*)(c.lds + 11 * GT); LAS float* ssb = (LAS float*)(c.lds + 12 * GT);
    const bool comp = w < 4; const int bi = (w >> 1) & 1, bj = w & 1;
    const bf16* gbase = c.ob16(OUT_GW) + (size_t)(bh * 64) * 4096;
    u32x4 lrA[5], lrB[5];
    f32x16 sreg;
#pragma unroll
    for (int i = 0; i < 16; ++i) sreg[i] = 0.f;
#define GDN_LOAD(SET, N) do { const bf16* gb_ = gbase + (size_t)(N) * 4096 + (tid >> 3) * 64 + (tid & 7) * 8; _Pragma("unroll") for (int t5 = 0; t5 < 5; ++t5) SET[t5] = __builtin_nontemporal_load((const u32x4*)(gb_ + (size_t)t5 * (16 * MiB / 2))); } while (0)
#define GDN_STORE(SET, N) do { const int bo_ = ((N) & 1) * 5 * GT + ((tid >> 3) * KP + (tid & 7) * 8) * 2; _Pragma("unroll") for (int t5 = 0; t5 < 5; ++t5) *(LAS u32x4*)(c.lds + bo_ + t5 * GT) = SET[t5]; } while (0)
    __syncthreads();
    for (int i = tid; i < 64 * KP / 2; i += NTHREADS) ((LAS unsigned*)Sb)[i] = 0u;
    GDN_LOAD(lrA, 0); GDN_LOAD(lrB, 1); GDN_STORE(lrA, 0);
    __syncthreads();
    const int zc_row0 = b * SEQ + 32 * bj + r32; const bf16* zbase = c.wsb(WS_PROJ) + (size_t)zc_row0 * PC + B_Z + 64 * h + 32 * bi + 4 * hi;
    u32x2 zc[4], zn[4]; float glc = 0.f, gln_ = 0.f; LAS float* gls = ssb + 128;
    if (tid < 64) gls[tid] = gln[tid];
#pragma unroll
    for (int q = 0; q < 4; ++q) { zc[q] = (u32x2){0u, 0u}; zn[q] = (u32x2){0u, 0u}; }
#pragma unroll
    for (int q = 0; q < 4; ++q) zc[q] = *(const u32x2*)(zbase + 8 * q);
    glc = c.wsf(WS_GL)[bh * 64];
#define GDN_STEP(N, LS, WS, ZU, ZP, GU, GP) do { const int n = (N); \
        const int bufo = (n & 1) * 5 * GT; \
        const LAS bf16* Wt = (const LAS bf16*)(c.lds + bufo); const LAS bf16* Ut = (const LAS bf16*)(c.lds + bufo + GT); const LAS bf16* QDt = (const LAS bf16*)(c.lds + bufo + 2 * GT); \
        const LAS bf16* KETt = (const LAS bf16*)(c.lds + bufo + 3 * GT); const LAS bf16* ATTt = (const LAS bf16*)(c.lds + bufo + 4 * GT); \
        f32x16 o; \
        { const int n2_ = n + 2 < 64 ? n + 2 : 63; GDN_LOAD(LS, n2_); const int n1_ = n + 1 < 64 ? n + 1 : 63; \
          _Pragma("unroll") for (int q = 0; q < 4; ++q) ZP[q] = *(const u32x2*)(zbase + (size_t)n1_ * 64 * PC + 8 * q); GP = c.wsf(WS_GL)[bh * 64 + n1_]; } \
        if (comp) { \
            f32x16 t; _Pragma("unroll") for (int i = 0; i < 16; ++i) t[i] = 0.f; \
            _Pragma("unroll") for (int s = 0; s < 4; ++s) { const bf16x8 a = *(const LAS bf16x8*)(Sb + (32 * bi + r32) * KP + 16 * s + 8 * hi), bb = *(const LAS bf16x8*)(Wt + (32 * bj + r32) * KP + 16 * s + 8 * hi); t = MFMA32(a, bb, t); } \
            _Pragma("unroll") for (int q = 0; q < 4; ++q) { const u32x2 u4 = *(const LAS u32x2*)(Ut + (32 * bj + r32) * KP + 32 * bi + 8 * q + 4 * hi); \
                const float v0 = bflo(u4.x) - t[4 * q], v1 = bfhi(u4.x) - t[4 * q + 1], v2 = bflo(u4.y) - t[4 * q + 2], v3 = bfhi(u4.y) - t[4 * q + 3]; \
                LAS bf16* vp = Vn + (32 * bi + 8 * q + 4 * hi) * KP + 32 * bj + r32; \
                vp[0] = f2bf(v0); vp[KP] = f2bf(v1); vp[2 * KP] = f2bf(v2); vp[3 * KP] = f2bf(v3); } \
        } \
        __syncthreads(); \
        if (comp) { \
            _Pragma("unroll") for (int i = 0; i < 16; ++i) o[i] = 0.f; \
            _Pragma("unroll") for (int s = 0; s < 4; ++s) { const bf16x8 a = *(const LAS bf16x8*)(Sb + (32 * bi + r32) * KP + 16 * s + 8 * hi), bb = *(const LAS bf16x8*)(QDt + (32 * bj + r32) * KP + 16 * s + 8 * hi); o = MFMA32(a, bb, o); } \
            const float dec = fexp(GU); \
            f32x16 sn; _Pragma("unroll") for (int i = 0; i < 16; ++i) sn[i] = sreg[i] * dec; \
            _Pragma("unroll") for (int s = 0; s < 4; ++s) { const bf16x8 a = *(const LAS bf16x8*)(Vn + (32 * bi + r32) * KP + 16 * s + 8 * hi); \
                const bf16x8 b1 = *(const LAS bf16x8*)(ATTt + (32 * bj + r32) * KP + 16 * s + 8 * hi), b2 = *(const LAS bf16x8*)(KETt + (32 * bj + r32) * KP + 16 * s + 8 * hi); \
                o = MFMA32(a, b1, o); sn = MFMA32(a, b2, sn); } \
            sreg = sn; \
            float sq = 0.f; _Pragma("unroll") for (int i = 0; i < 16; ++i) sq += o[i] * o[i]; \
            sq += shx(sq, 32); \
            if (hi == 0) ssb[bi * 64 + 32 * bj + r32] = sq; \
        } \
        __syncthreads(); \
        if (comp) { \
            _Pragma("unroll") for (int i = 0; i < 16; ++i) Sb[(32 * bi + crow(i, hi)) * KP + 32 * bj + r32] = f2bf(sreg[i]); \
            const int cc = 32 * bj + r32; const float rs = rsq((ssb[cc] + ssb[64 + cc]) * (1.f / 64) + EPS); \
            const int row = b * SEQ + n * 64 + cc; bf16* yp = c.wsb(WS_HN) + (size_t)row * DM + 256 + 64 * h; \
            _Pragma("unroll") for (int q = 0; q < 4; ++q) { const int dv = 32 * bi + 8 * q + 4 * hi; const u32x2 z = ZU[q]; const f32x4 g = *(const LAS f32x4*)(gls + dv); \
                u32x2 wv; wv.x = pk2(o[4 * q] * rs * g[0] * silu(bflo(z.x)), o[4 * q + 1] * rs * g[1] * silu(bfhi(z.x))); \
                wv.y = pk2(o[4 * q + 2] * rs * g[2] * silu(bflo(z.y)), o[4 * q + 3] * rs * g[3] * silu(bfhi(z.y))); *(u32x2*)(yp + dv) = wv; } \
        } \
        GDN_STORE(WS, n + 1); \
        __syncthreads(); } while (0)
#pragma unroll 1
    for (int n2 = 0; n2 < 64; n2 += 2) { GDN_STEP(n2, lrA, lrB, zc, zn, glc, gln_); GDN_STEP(n2 + 1, lrB, lrA, zn, zc, gln_, glc); }
#undef GDN_STEP
#undef GDN_LOAD
#undef GDN_STORE
}

constexpr float MKS = 0.17677669529663687f;
DI void mlstm_gates(const Ctx& c, int b, int h, int n, int lane, float& ig, float& bcum) {
    const bf16* pr = c.wsb(WS_PROJ) + (size_t)(b * SEQ + n * 64 + lane) * PC + SMC;
    const float ip = bf2f(pr[20 + h]) + c.in[13][c.l * 4 + h], fp = bf2f(pr[24 + h]) + c.in[14][c.l * 4 + h];
    ig = 15.f * tanh_(ip * (1.f / 15.f)); float lf = -softplus_(-15.f * tanh_(fp * (1.f / 15.f)));
#pragma unroll
    for (int o = 1; o < 64; o <<= 1) { const float t = shu(lf, o); if (lane >= o) lf += t; }
    bcum = lf;
}
DI void mlstm_prep_item(const Ctx& c, int item) {
    const int n = item & 63, h = (item >> 6) & 3, b = item >> 8; int tid = c.tid; asm volatile("" : "+v"(tid));
    LAS float* kk = (LAS float*)c.lds; LAS float* vv = kk + 64 * 33; LAS float* wend = vv + 64 * 65;
    const bf16* proj = c.wsb(WS_PROJ);
    __syncthreads();
    for (int e = tid; e < 64 * 32; e += NTHREADS) { const int r = e >> 5, d = e & 31; kk[r * 33 + d] = bf2f(proj[(size_t)(b * SEQ + n * 64 + r) * PC + C_K + 32 * h + d]) * MKS; }
    for (int e = tid; e < 64 * 64; e += NTHREADS) { const int r = e >> 6, d = e & 63; vv[r * 65 + d] = bf2f(proj[(size_t)(b * SEQ + n * 64 + r) * PC + C_V + 64 * h + d]); }
    if (tid < 64) { float ig, bc; mlstm_gates(c, b, h, n, tid, ig, bc); const float bl = __builtin_bit_cast(float, __builtin_amdgcn_readlane(__builtin_bit_cast(int, bc), 63)); const float ae = bl - bc + ig; const float ml = wmax(ae);
        wend[tid] = fexp(ae - ml); if (tid == 0) { c.wsf(WS_MLOC)[item] = ml; c.wsf(WS_BLAST)[item] = bl; } }
    __syncthreads();
    { const int dv = tid >> 3, dk0 = (tid & 7) * 4; float a[4] = {0.f, 0.f, 0.f, 0.f};
        for (int r = 0; r < 64; ++r) { const float wv = wend[r] * vv[r * 65 + dv];
#pragma unroll
            for (int q = 0; q < 4; ++q) a[q] += wv * kk[r * 33 + dk0 + q]; }
        *(f32x4*)(c.of32(OUT_CLOC) + (size_t)item * 2048 + dv * 32 + dk0) = (f32x4){a[0], a[1], a[2], a[3]}; }
    if (tid < 32) { float a = 0.f; for (int r = 0; r < 64; ++r) a += wend[r] * kk[r * 33 + tid]; c.wsf(WS_NLOC)[(size_t)item * 32 + tid] = a; }
}
DI void mlstm_scan_item(const Ctx& c, int bh) {
    int tid = c.tid; asm volatile("" : "+v"(tid)); f32x4 cs = {0.f, 0.f, 0.f, 0.f}; float ns = 0.f, ms = 0.f;
#pragma unroll 1
    for (int n0 = 0; n0 < 64; n0 += 8) {
        f32x4 cl[8]; float nl[8], ml[8], bl[8];
#pragma unroll
        for (int j = 0; j < 8; ++j) { const size_t it = (size_t)bh * 64 + n0 + j;
            cl[j] = *(const f32x4*)(c.of32(OUT_CLOC) + it * 2048 + tid * 4); nl[j] = (tid < 32) ? c.wsf(WS_NLOC)[it * 32 + tid] : 0.f; ml[j] = c.wsf(WS_MLOC)[it]; bl[j] = c.wsf(WS_BLAST)[it]; }
#pragma unroll
        for (int j = 0; j < 8; ++j) { const size_t it = (size_t)bh * 64 + n0 + j;
            *(f32x4*)(c.of32(OUT_CIN) + it * 2048 + tid * 4) = cs; if (tid < 32) c.wsf(WS_NIN)[it * 32 + tid] = ns; if (tid == 0) c.wsf(WS_MIN)[it] = ms;
            const float mn = fmaxf(bl[j] + ms, ml[j]), sp = fexp(bl[j] + ms - mn), sl = fexp(ml[j] - mn);
            cs = cs * sp + cl[j] * sl; ns = ns * sp + nl[j] * sl; ms = mn; }
    }
}
DI void mlstm_out_item(const Ctx& c, int item) {
    const int n = item & 63, h = (item >> 6) & 3, b = item >> 8; int tid = c.tid; asm volatile("" : "+v"(tid));
    LAS float* qq = (LAS float*)c.lds; LAS float* kk = qq + 64 * 33; LAS float* vv = kk + 64 * 33; LAS float* cin = vv + 64 * 65; LAS float* Wm = cin + 64 * 33;
    LAS float* bcs = Wm + 64 * 65; LAS float* igs = bcs + 64; LAS float* mts = igs + 64; LAS float* wint = mts + 64; LAS float* nin = wint + 64;
    const bf16* proj = c.wsb(WS_PROJ);
    __syncthreads();
    for (int e = tid; e < 64 * 32; e += NTHREADS) { const int r = e >> 5, d = e & 31; const bf16* pr = proj + (size_t)(b * SEQ + n * 64 + r) * PC;
        qq[r * 33 + d] = bf2f(pr[C_Q + 32 * h + d]); kk[r * 33 + d] = bf2f(pr[C_K + 32 * h + d]) * MKS; }
    for (int e = tid; e < 64 * 64; e += NTHREADS) { const int r = e >> 6, d = e & 63; vv[r * 65 + d] = bf2f(proj[(size_t)(b * SEQ + n * 64 + r) * PC + C_V + 64 * h + d]); }
    for (int e = tid; e < 64 * 32; e += NTHREADS) { const int dv = e >> 5, dk = e & 31; cin[dv * 33 + dk] = c.of32(OUT_CIN)[(size_t)item * 2048 + e]; }
    if (tid < 32) nin[tid] = c.wsf(WS_NIN)[(size_t)item * 32 + tid];
    if (tid < 64) { float ig, bc; mlstm_gates(c, b, h, n, tid, ig, bc); float pm = ig - bc;
#pragma unroll
        for (int o = 1; o < 64; o <<= 1) { const float t = shu(pm, o); if (tid >= o) pm = fmaxf(pm, t); }
        const float mi = c.wsf(WS_MIN)[item]; const float mt = bc + fmaxf(mi, pm);
        bcs[tid] = bc; igs[tid] = ig; mts[tid] = mt; wint[tid] = fexp(bc + mi - mt); }
    __syncthreads();
    const int ty = tid >> 4, tx = tid & 15, i0 = 2 * ty, j0 = 4 * tx;
    { float qk[2][4];
#pragma unroll
        for (int a = 0; a < 2; ++a)
#pragma unroll
            for (int q = 0; q < 4; ++q) qk[a][q] = 0.f;
        for (int k = 0; k < 32; ++k) { const float q0 = qq[i0 * 33 + k], q1 = qq[(i0 + 1) * 33 + k];
#pragma unroll
            for (int q = 0; q < 4; ++q) { const float kj = kk[(j0 + q) * 33 + k]; qk[0][q] += q0 * kj; qk[1][q] += q1 * kj; } }
#pragma unroll
        for (int a = 0; a < 2; ++a) { const int i = i0 + a;
#pragma unroll
            for (int q = 0; q < 4; ++q) { const int s = j0 + q; Wm[i * 65 + s] = (s <= i) ? fexp(bcs[i] - bcs[s] + igs[s] - mts[i]) * qk[a][q] : 0.f; } } }
    __syncthreads();
    { float num[2][4], rsum[2] = {0.f, 0.f}, inter[2][4], qn[2] = {0.f, 0.f};
#pragma unroll
        for (int a = 0; a < 2; ++a)
#pragma unroll
            for (int q = 0; q < 4; ++q) { num[a][q] = 0.f; inter[a][q] = 0.f; }
        for (int s = 0; s < 64; ++s) { const float w0 = Wm[i0 * 65 + s], w1 = Wm[(i0 + 1) * 65 + s]; rsum[0] += w0; rsum[1] += w1;
#pragma unroll
            for (int q = 0; q < 4; ++q) { const float ve = vv[s * 65 + j0 + q]; num[0][q] += w0 * ve; num[1][q] += w1 * ve; } }
        for (int k = 0; k < 32; ++k) { const float q0 = qq[i0 * 33 + k], q1 = qq[(i0 + 1) * 33 + k], nk = nin[k]; qn[0] += q0 * nk; qn[1] += q1 * nk;
#pragma unroll
            for (int q = 0; q < 4; ++q) { const float ce = cin[(j0 + q) * 33 + k]; inter[0][q] += q0 * ce; inter[1][q] += q1 * ce; } }
        const float* ng = c.in[15] + (size_t)c.l * 64;
#pragma unroll
        for (int a = 0; a < 2; ++a) { const int i = i0 + a; const float wi = wint[i]; const float den = wi * qn[a] + rsum[a]; const float dd = fmaxf(fabsf(den), fexp(-mts[i])); const float inv = 1.f / dd;
            float hv[4]; float ss = 0.f;
#pragma unroll
            for (int q = 0; q < 4; ++q) { hv[q] = (wi * inter[a][q] + num[a][q]) * inv; ss += hv[q] * hv[q]; }
            ss += shx(ss, 1); ss += shx(ss, 2); ss += shx(ss, 4); ss += shx(ss, 8);
            const float rs = rsq(ss * (1.f / 64) + EPS); const int row = b * SEQ + n * 64 + i;
            const u32x2 op = *(const u32x2*)(proj + (size_t)row * PC + C_O + 64 * h + j0); const f32x4 g = *(const f32x4*)(ng + j0);
            u32x2 wv; wv.x = pk2(hv[0] * rs * g[0] * sigm(bflo(op.x)), hv[1] * rs * g[1] * sigm(bfhi(op.x))); wv.y = pk2(hv[2] * rs * g[2] * sigm(bflo(op.y)), hv[3] * rs * g[3] * sigm(bfhi(op.y)));
            *(u32x2*)(c.wsb(WS_HN) + (size_t)row * DM + 512 + 64 * h + j0) = wv; } }
}

DI void mlstm_prep_mf(const Ctx& c, int item2) {
    const int n = item2 & 63, b = item2 >> 6; int tid = c.tid; asm volatile("" : "+v"(tid)); const int lane = tid & 63, w = __builtin_amdgcn_readfirstlane(tid >> 6), r32 = lane & 31, hi = lane >> 5;
    constexpr int VTW = 64 * VP * 2, KTT = 32 * KP * 2, HB = VTW + KTT + 256;
    const bf16* proj = c.wsb(WS_PROJ); const int row0 = b * SEQ + n * 64;
    __syncthreads();
    const int cc = tid & 63;
    u32x4 vv[4], kv[2];
#pragma unroll
    for (int i = 0; i < 4; ++i) { const int idx = (tid >> 6) + 8 * i; vv[i] = *(const u32x4*)(proj + (size_t)(row0 + cc) * PC + C_V + 8 * idx); }
#pragma unroll
    for (int i = 0; i < 2; ++i) { const int idx = (tid >> 6) + 8 * i; kv[i] = *(const u32x4*)(proj + (size_t)(row0 + cc) * PC + C_K + 8 * idx); }
    if (w < 4) { const int h = w; float ig, bc; mlstm_gates(c, b, h, n, lane, ig, bc); const float bl = __builtin_bit_cast(float, __builtin_amdgcn_readlane(__builtin_bit_cast(int, bc), 63)); const float ae = bl - bc + ig; const float ml = wmax(ae);
        ((LAS float*)(c.lds + h * HB + VTW + KTT))[lane] = fexp(ae - ml);
        if (lane == 0) { const int it = (b * 4 + h) * 64 + n; c.wsf(WS_MLOC)[it] = ml; c.wsf(WS_BLAST)[it] = bl; } }
    __syncthreads();
    {
#pragma unroll
        for (int i = 0; i < 4; ++i) { const int idx = (tid >> 6) + 8 * i, h = idx >> 3, ch = idx & 7; const float we = ((const LAS float*)(c.lds + h * HB + VTW + KTT))[cc];
            LAS bf16* p = (LAS bf16*)(c.lds + h * HB) + (8 * ch) * VP + cc; const u32x4 v = vv[i];
            p[0] = f2bf(bflo(v.x) * we); p[VP] = f2bf(bfhi(v.x) * we); p[2 * VP] = f2bf(bflo(v.y) * we); p[3 * VP] = f2bf(bfhi(v.y) * we);
            p[4 * VP] = f2bf(bflo(v.z) * we); p[5 * VP] = f2bf(bfhi(v.z) * we); p[6 * VP] = f2bf(bflo(v.w) * we); p[7 * VP] = f2bf(bfhi(v.w) * we); }
#pragma unroll
        for (int i = 0; i < 2; ++i) { const int idx = (tid >> 6) + 8 * i, h = idx >> 2, ch = idx & 3;
            LAS bf16* p = (LAS bf16*)(c.lds + h * HB + VTW) + (8 * ch) * KP + cc; const u32x4 v = kv[i];
            p[0] = (bf16)(v.x & 0xffffu); p[KP] = (bf16)(v.x >> 16); p[2 * KP] = (bf16)(v.y & 0xffffu); p[3 * KP] = (bf16)(v.y >> 16);
            p[4 * KP] = (bf16)(v.z & 0xffffu); p[5 * KP] = (bf16)(v.z >> 16); p[6 * KP] = (bf16)(v.w & 0xffffu); p[7 * KP] = (bf16)(v.w >> 16); }
    }
    __syncthreads();
    { const int h = w >> 1, blk = w & 1; const int it = (b * 4 + h) * 64 + n;
        const LAS bf16* Vw = (const LAS bf16*)(c.lds + h * HB); const LAS bf16* Kx = (const LAS bf16*)(c.lds + h * HB + VTW); const LAS float* we = (const LAS float*)(c.lds + h * HB + VTW + KTT);
        f32x16 acc;
#pragma unroll
        for (int i = 0; i < 16; ++i) acc[i] = 0.f;
#pragma unroll
        for (int s = 0; s < 4; ++s) { const LAS bf16* ap = Vw + (32 * blk + r32) * VP + 16 * s + 8 * hi;
            const u32x2 lo = *(const LAS u32x2*)ap, hi2 = *(const LAS u32x2*)(ap + 4); u32x4 af; af.x = lo.x; af.y = lo.y; af.z = hi2.x; af.w = hi2.y;
            const bf16x8 bfm = *(const LAS bf16x8*)(Kx + r32 * KP + 16 * s + 8 * hi);
            acc = MFMA32(__builtin_bit_cast(bf16x8, af), bfm, acc); }
        float* dst = c.of32(OUT_CLOC) + (size_t)it * 2048;
#pragma unroll
        for (int i = 0; i < 16; ++i) dst[(32 * blk + crow(i, hi)) * 32 + r32] = acc[i] * MKS;
        if (blk == 0 && lane < 32) { float a = 0.f;
#pragma unroll 8
            for (int cc = 0; cc < 64; ++cc) a += we[cc] * bf2f(Kx[lane * KP + cc]);
            c.wsf(WS_NLOC)[(size_t)it * 32 + lane] = a * MKS; }
    }
}
DI void mlstm_out_mf(const Ctx& c, int item2) {
    const int n = item2 & 63, b = item2 >> 6; int tid = c.tid; asm volatile("" : "+v"(tid)); const int lane = tid & 63, w = __builtin_amdgcn_readfirstlane(tid >> 6), r32 = lane & 31, hi = lane >> 5;
    constexpr int KTB = 64 * 40 * 2, VTB = 64 * VP * 2, CTB = 64 * 40 * 2, HB = KTB + VTB + CTB + 5 * 256;
    const bf16* proj = c.wsb(WS_PROJ); const int row0 = b * SEQ + n * 64;
    __syncthreads();
    const int h2 = w >> 1, cl2 = 32 * (w & 1) + r32; const bf16* prow2 = proj + (size_t)(row0 + cl2) * PC;
    bf16x8 qf[2]; u32x2 og0[4], og1[4]; f32x4 gn0[4], gn1[4]; const float* ng = c.in[15] + (size_t)c.l * 64;
#pragma unroll
    for (int q = 0; q < 4; ++q) { gn0[q] = *(const f32x4*)(ng + 8 * q + 4 * hi); gn1[q] = *(const f32x4*)(ng + 32 + 8 * q + 4 * hi); }
#pragma unroll
    for (int ks = 0; ks < 2; ++ks) qf[ks] = *(const bf16x8*)(prow2 + C_Q + 32 * h2 + 16 * ks + 8 * hi);
#pragma unroll
    for (int q = 0; q < 4; ++q) { og0[q] = *(const u32x2*)(prow2 + C_O + 64 * h2 + 8 * q + 4 * hi); og1[q] = *(const u32x2*)(prow2 + C_O + 64 * h2 + 32 + 8 * q + 4 * hi); }
    const int cc = tid & 63;
    u32x4 vv[4], kv[2]; f32x4 cv[4];
#pragma unroll
    for (int i = 0; i < 4; ++i) { const int idx = (tid >> 6) + 8 * i; vv[i] = *(const u32x4*)(proj + (size_t)(row0 + cc) * PC + C_V + 8 * idx); }
#pragma unroll
    for (int i = 0; i < 2; ++i) { const int e = tid + 512 * i; const int s_ = e >> 4, q = e & 15; kv[i] = *(const u32x4*)(proj + (size_t)(row0 + s_) * PC + C_K + 8 * q); }
#pragma unroll
    for (int i = 0; i < 4; ++i) { const int e = tid + 512 * i; const int h = e >> 9, q = e & 511; cv[i] = *(const f32x4*)(c.of32(OUT_CIN) + (size_t)((b * 4 + h) * 64 + n) * 2048 + 4 * q); }
    float mi_pre = 0.f, nin_pre = 0.f;
    if (w < 4) { const int it = (b * 4 + w) * 64 + n; mi_pre = c.wsf(WS_MIN)[it]; if (lane < 32) nin_pre = c.wsf(WS_NIN)[(size_t)it * 32 + lane]; }
    if (w < 4) { const int h = w; float ig, bc; mlstm_gates(c, b, h, n, lane, ig, bc); float pm = ig - bc; const float dsv = pm;
#pragma unroll
        for (int o = 1; o < 64; o <<= 1) { const float t = shu(pm, o); if (lane >= o) pm = fmaxf(pm, t); }
        const float mi = mi_pre; const float mt = bc + fmaxf(mi, pm);
        LAS float* ga = (LAS float*)(c.lds + h * HB + KTB + VTB + CTB);
        ga[lane] = bc; ga[64 + lane] = dsv; ga[128 + lane] = mt; ga[192 + lane] = fexp(bc + mi - mt); if (lane < 32) ga[256 + lane] = nin_pre; }
    {
#pragma unroll
        for (int i = 0; i < 4; ++i) { const int idx = (tid >> 6) + 8 * i, h = idx >> 3, ch = idx & 7;
            LAS bf16* p = (LAS bf16*)(c.lds + h * HB + KTB) + (8 * ch) * VP + cc; const u32x4 v = vv[i];
            p[0] = (bf16)(v.x & 0xffffu); p[VP] = (bf16)(v.x >> 16); p[2 * VP] = (bf16)(v.y & 0xffffu); p[3 * VP] = (bf16)(v.y >> 16);
            p[4 * VP] = (bf16)(v.z & 0xffffu); p[5 * VP] = (bf16)(v.z >> 16); p[6 * VP] = (bf16)(v.w & 0xffffu); p[7 * VP] = (bf16)(v.w >> 16); }
#pragma unroll
        for (int i = 0; i < 2; ++i) { const int e = tid + 512 * i; const int s_ = e >> 4, q = e & 15, h = q >> 2, ch = q & 3;
            *(LAS u32x4*)((LAS bf16*)(c.lds + h * HB) + s_ * 40 + 8 * ch) = kv[i]; }
#pragma unroll
        for (int i = 0; i < 4; ++i) { const int e = tid + 512 * i; const int h = e >> 9, q = e & 511, ev = q >> 3, dk = (q & 7) * 4;
            u32x2 pkd; pkd.x = pk2(cv[i][0], cv[i][1]); pkd.y = pk2(cv[i][2], cv[i][3]);
            *(LAS u32x2*)((LAS bf16*)(c.lds + h * HB + KTB + VTB) + ev * 40 + dk) = pkd; }
    }
    __syncthreads();
    { const int h = w >> 1, chf = w & 1; const int cl = 32 * chf + r32, row = row0 + cl;
        const LAS bf16* Kt = (const LAS bf16*)(c.lds + h * HB); const LAS bf16* Vt = (const LAS bf16*)(c.lds + h * HB + KTB); const LAS bf16* Ct = (const LAS bf16*)(c.lds + h * HB + KTB + VTB);
        const LAS float* ga = (const LAS float*)(c.lds + h * HB + KTB + VTB + CTB);
        const float bc_c = ga[cl], mt_c = ga[128 + cl], wi_c = ga[192 + cl];
        f32x16 x0, x1;
#pragma unroll
        for (int i = 0; i < 16; ++i) { x0[i] = 0.f; x1[i] = 0.f; }
#pragma unroll
        for (int ks = 0; ks < 2; ++ks) { x0 = MFMA32(*(const LAS bf16x8*)(Kt + r32 * 40 + 16 * ks + 8 * hi), qf[ks], x0); }
        if (chf) {
#pragma unroll
            for (int ks = 0; ks < 2; ++ks) x1 = MFMA32(*(const LAS bf16x8*)(Kt + (32 + r32) * 40 + 16 * ks + 8 * hi), qf[ks], x1); }
        float rsum = 0.f; const float e0 = bc_c - mt_c;
#pragma unroll
        for (int i = 0; i < 16; ++i) { const int s0 = crow(i, hi), s1 = 32 + s0;
            const float w0 = (s0 <= cl) ? fexp(e0 + ga[64 + s0]) * x0[i] * MKS : 0.f; const float w1 = (s1 <= cl) ? fexp(e0 + ga[64 + s1]) * x1[i] * MKS : 0.f;
            x0[i] = w0; x1[i] = w1; rsum += w0 + w1; }
        rsum += shx(rsum, 32);
        f32x16 n0, n1;
#pragma unroll
        for (int i = 0; i < 16; ++i) { n0[i] = 0.f; n1[i] = 0.f; }
        pv_tile(n0, n1, pack8(x0, 0), pack8(x0, 1), pack8(x1, 0), pack8(x1, 1), Vt, r32, hi);
        f32x16 i0, i1;
#pragma unroll
        for (int i = 0; i < 16; ++i) { i0[i] = 0.f; i1[i] = 0.f; }
#pragma unroll
        for (int ks = 0; ks < 2; ++ks) { i0 = MFMA32(*(const LAS bf16x8*)(Ct + r32 * 40 + 16 * ks + 8 * hi), qf[ks], i0); i1 = MFMA32(*(const LAS bf16x8*)(Ct + (32 + r32) * 40 + 16 * ks + 8 * hi), qf[ks], i1); }
        float qn = 0.f;
#pragma unroll
        for (int ks = 0; ks < 2; ++ks) { const u32x4 qq = __builtin_bit_cast(u32x4, qf[ks]); const LAS float* np = ga + 256 + 16 * ks + 8 * hi;
            qn += bflo(qq.x) * np[0] + bfhi(qq.x) * np[1] + bflo(qq.y) * np[2] + bfhi(qq.y) * np[3] + bflo(qq.z) * np[4] + bfhi(qq.z) * np[5] + bflo(qq.w) * np[6] + bfhi(qq.w) * np[7]; }
        qn += shx(qn, 32);
        const float den = wi_c * qn + rsum; const float inv = 1.f / fmaxf(fabsf(den), fexp(-mt_c));
        float ss = 0.f;
#pragma unroll
        for (int i = 0; i < 16; ++i) { n0[i] = (wi_c * i0[i] + n0[i]) * inv; n1[i] = (wi_c * i1[i] + n1[i]) * inv; ss += n0[i] * n0[i] + n1[i] * n1[i]; }
        ss += shx(ss, 32);
        const float rs = rsq(ss * (1.f / 64) + EPS);
        bf16* y = c.wsb(WS_HN) + (size_t)row * DM + 512 + 64 * h;
#pragma unroll
        for (int q = 0; q < 4; ++q) { const int d = 8 * q + 4 * hi; const f32x4 g0 = gn0[q], g1 = gn1[q]; const u32x2 o0 = og0[q], o1 = og1[q];
            u32x2 w0; w0.x = pk2(n0[4 * q] * rs * g0[0] * sigm(bflo(o0.x)), n0[4 * q + 1] * rs * g0[1] * sigm(bfhi(o0.x))); w0.y = pk2(n0[4 * q + 2] * rs * g0[2] * sigm(bflo(o0.y)), n0[4 * q + 3] * rs * g0[3] * sigm(bfhi(o0.y))); *(u32x2*)(y + d) = w0;
            u32x2 w1; w1.x = pk2(n1[4 * q] * rs * g1[0] * sigm(bflo(o1.x)), n1[4 * q + 1] * rs * g1[1] * sigm(bfhi(o1.x))); w1.y = pk2(n1[4 * q + 2] * rs * g1[2] * sigm(bflo(o1.y)), n1[4 * q + 3] * rs * g1[3] * sigm(bfhi(o1.y))); *(u32x2*)(y + 32 + d) = w1; }
    }
}

DI void phase_norm_route(const Ctx& c, bool dry) {
    constexpr int WP = 1032;
    LAS bf16* wl = (LAS bf16*)c.lds;
    LAS float* lg = (LAS float*)(c.lds + 48 * WP * 2) + c.wave * (16 * 52);
    LAS int* hist = (LAS int*)(c.lds + 48 * WP * 2 + 8 * 16 * 52 * 4);
    bf16* hn = c.wsb(WS_HN);
    const bf16* whi = c.wsb(WS_WRT) + (size_t)(c.l * 2) * 65536;
    const float* bg = c.in[27] + c.l * 4; const float* be = c.in[29] + c.l * 32;
    const int t16 = c.lane & 15, g = c.lane >> 4;
    __syncthreads();
    { u32x4 wreg[12];
#pragma unroll
        for (int q = 0; q < 12; ++q) { const int i = c.tid + NTHREADS * q; const int e = i >> 7, ch = i & 127; wreg[q] = *(const u32x4*)(whi + (size_t)e * 1024 + 8 * ch); }
#pragma unroll
        for (int q = 0; q < 12; ++q) { const int i = c.tid + NTHREADS * q; const int e = i >> 7, ch = i & 127; *(LAS u32x4*)(wl + e * WP + 8 * ch) = wreg[q]; } }
    for (int tile = c.gw; tile < T / 16; tile += c.ngw) {
        __syncthreads();
        if (c.tid < 32) hist[c.tid] = 0;
        __syncthreads();
        const int row = 16 * tile + t16; const bf16* hp = c.wsb(WS_RES) + (size_t)row * DM + 8 * g;
        const LAS bf16* wr = wl + t16 * WP + 8 * g;
        f32x4 a0 = {0.f, 0.f, 0.f, 0.f}, a1 = a0, a2 = a0;
        float ss = 0.f;
#pragma unroll 8
        for (int s = 0; s < 32; ++s) {
            const u32x4 ph = *(const u32x4*)(hp + 32 * s);
            const bf16x8 h0 = *(const LAS bf16x8*)(wr + 32 * s), h1 = *(const LAS bf16x8*)(wr + 16 * WP + 32 * s), h2 = *(const LAS bf16x8*)(wr + 32 * WP + 32 * s);
            { const float x0 = bflo(ph.x), x1 = bfhi(ph.x), x2 = bflo(ph.y), x3 = bfhi(ph.y), x4 = bflo(ph.z), x5 = bfhi(ph.z), x6 = bflo(ph.w), x7 = bfhi(ph.w);
              ss += (x0 * x0 + x1 * x1) + (x2 * x2 + x3 * x3) + (x4 * x4 + x5 * x5) + (x6 * x6 + x7 * x7); }
            const bf16x8 xh = __builtin_bit_cast(bf16x8, ph);
            a0 = __builtin_amdgcn_mfma_f32_16x16x32_bf16(h0, xh, a0, 0, 0, 0);
            a1 = __builtin_amdgcn_mfma_f32_16x16x32_bf16(h1, xh, a1, 0, 0, 0);
            a2 = __builtin_amdgcn_mfma_f32_16x16x32_bf16(h2, xh, a2, 0, 0, 0);
        }
        ss += shx(ss, 16); ss += shx(ss, 32);
        const float rs = rsq(ss * (1.f / DM) + EPS);
        if (g == 0) c.wsf(WS_RS)[row] = rs;
#pragma unroll
        for (int r = 0; r < 4; ++r) { lg[t16 * 52 + 4 * g + r] = a0[r] * rs; lg[t16 * 52 + 16 + 4 * g + r] = a1[r] * rs; lg[t16 * 52 + 32 + 4 * g + r] = a2[r] * rs; }
        LDS_WAIT();
        if (c.lane < 16) { const LAS float* Lg = lg + c.lane * 52;
            int gi = 0; float gm = Lg[0] + bg[0];
            for (int i = 1; i < 4; ++i) { const float v = Lg[i] + bg[i]; if (v > gm) { gm = v; gi = i; } }
            float gs = 0.f; for (int i = 0; i < 4; ++i) gs += fexp(Lg[i] + bg[i] - gm);
            const float gp = 1.f / gs;
            int i1 = 0; float m1 = -1e30f, m2 = -1e30f; int i2 = 0;
            for (int i = 0; i < 8; ++i) { const float v = Lg[4 + gi * 8 + i] + be[gi * 8 + i]; if (v > m1) { m2 = m1; i2 = i1; m1 = v; i1 = i; } else if (v > m2) { m2 = v; i2 = i; } }
            const float p2 = fexp(m2 - m1); const float w1_ = gp / (1.f + p2), w2_ = gp * p2 / (1.f + p2);
            const int e1 = gi * 8 + i1, e2 = gi * 8 + i2; const int rw = 16 * tile + c.lane;
            c.wsi(WS_TOKE)[2 * rw] = e1; c.wsi(WS_TOKE)[2 * rw + 1] = e2; c.wsf(WS_TOKW)[2 * rw] = w1_; c.wsf(WS_TOKW)[2 * rw + 1] = w2_;
            __hip_atomic_fetch_add(hist + e1, 1, __ATOMIC_RELAXED, __HIP_MEMORY_SCOPE_WORKGROUP); __hip_atomic_fetch_add(hist + e2, 1, __ATOMIC_RELAXED, __HIP_MEMORY_SCOPE_WORKGROUP); }
        __syncthreads();
        if (c.tid < 32) c.wsi(WS_BLKCNT)[(tile >> 3) * 32 + c.tid] = hist[c.tid];
    }
    (void)dry;
}
DI void moe_tiles(const Ctx& c, LAS int* tb, LAS unsigned char* t2e, const LAS int* ltot = nullptr) {
    __syncthreads();
    if (c.tid < 64) { const int n = (c.tid < 32) ? ((ltot ? ltot[c.tid] : c.wsi(WS_MCNT)[c.tid]) + 255) >> 8 : 0; int inc = n;
#pragma unroll
        for (int o = 1; o < 32; o <<= 1) { const int t = shu(inc, o); if (c.tid >= o) inc += t; }
        if (c.tid < 32) tb[c.tid] = inc - n; if (c.tid == 31) tb[32] = inc; }
    __syncthreads();
    if (c.tid < 320) { int e = 0;
#pragma unroll 1
        for (int k = 1; k < 32; ++k) if (c.tid >= tb[k]) e = k;
        t2e[c.tid] = (unsigned char)e; }
    __syncthreads();
}
DI void phase_moe_slots(const Ctx& c, bool dry) {
    LAS int* tb = (LAS int*)(c.lds + LDS_MISC + 64); LAS unsigned char* t2e = (LAS unsigned char*)(c.lds + LDS_MISC + 256);
    LAS int* lcnt = (LAS int*)(c.lds); LAS int* lbase = lcnt + 32; LAS int* ltot = lcnt + 64; LAS int* ptot = lcnt + 128; LAS int* ppre = ptot + 512;
    (void)dry;
    const int* bc = c.wsi(WS_BLKCNT);
    for (int blk = c.blk; blk < 256; blk += c.G) {
        __syncthreads();
        {
            const int e = c.tid & 31, part = c.tid >> 5; int v[16]; int tsum = 0, psum = 0;
#pragma unroll
            for (int i = 0; i < 16; ++i) v[i] = bc[(part * 16 + i) * 32 + e];
#pragma unroll
            for (int i = 0; i < 16; ++i) { tsum += v[i]; psum += (part * 16 + i < blk) ? v[i] : 0; }
            ptot[part * 32 + e] = tsum; ppre[part * 32 + e] = psum; }
        if (c.tid < 32) lcnt[c.tid] = 0;
        __syncthreads();
        if (c.tid < 32) { int t_ = 0, p_ = 0;
#pragma unroll
            for (int k = 0; k < 16; ++k) { t_ += ptot[k * 32 + c.tid]; p_ += ppre[k * 32 + c.tid]; }
            ltot[c.tid] = t_; lbase[c.tid] = p_; if (blk == 0) c.wsi(WS_MCNT)[c.tid] = t_; }
        moe_tiles(c, tb, t2e, ltot);
        int e = 0, rank = 0, token = 0, which = 0;
        if (c.tid < 256) { token = blk * 128 + (c.tid >> 1); which = c.tid & 1; e = c.wsi(WS_TOKE)[2 * token + which]; rank = __hip_atomic_fetch_add(lcnt + e, 1, __ATOMIC_RELAXED, __HIP_MEMORY_SCOPE_WORKGROUP); }
        __syncthreads();
        if (c.tid < 256) { const int slot = 256 * tb[e] + lbase[e] + rank; c.wsi(WS_SLOTTOK)[slot] = token; c.wsi(WS_TOKS)[2 * token + which] = slot; }
        if (blk < 32) { const int lo = 256 * tb[blk] + ltot[blk], hi = 256 * tb[blk + 1]; for (int q = lo + c.tid; q < hi; q += NTHREADS) c.wsi(WS_SLOTTOK)[q] = 0; }
    }
}

struct CmpOrder {
    int G, c; const bf16* a0; const bf16* a1; const bf16* b0; const bf16* b1; size_t atile;
    DI bool next(int i, pg8::Unit& u) const { if (c < 0) return false; const int L = i * G + c; if (L >= 16) return false; u.kind = L >> 3; u.pm = L & 7; u.pn = 0; u.e = 0; u.half = 0; u.rofs = 0; return true; }
    DI const char* abase(const pg8::Gemm&, const pg8::Unit& u) const { return (const char*)(u.kind ? a1 : a0) + (size_t)u.pm * atile; }
    DI const char* bbase(const pg8::Gemm&, const pg8::Unit& u) const { return (const char*)(u.kind ? b1 : b0); }
    DI int arow(const pg8::Unit&, int r) const { return r; }
};
struct XqkvOrder {
    int G, c; const bf16* hn; const bf16* memn; const bf16* wq; const bf16* wkv;
    DI bool next(int i, pg8::Unit& u) const { const int L = i * G + c; if (L >= 144) return false;
        if (L < 128) { u.kind = 0; u.pm = L; u.pn = 0; } else { u.kind = 1; u.pm = (L - 128) >> 1; u.pn = (L - 128) & 1; } u.e = i & 15; u.half = 0; u.rofs = 0; return true; }
    DI const char* abase(const pg8::Gemm&, const pg8::Unit& u) const { return (const char*)(u.kind ? memn : hn) + (size_t)u.pm * 256 * DM * 2; }
    DI const char* bbase(const pg8::Gemm&, const pg8::Unit& u) const { return (const char*)(u.kind ? wkv : wq) + (size_t)u.pn * 256 * DM * 2; }
    DI int arow(const pg8::Unit&, int r) const { return r; }
};
struct MoeOrder {
    int G, c, npn, lognpn; const LAS int* tb; const LAS unsigned char* t2e; const int* slottok; const bf16* bw; size_t bexp, btile;
    DI bool next(int i, pg8::Unit& u) const {
        const int cp = (G % 8 == 0 && EXPT != 80) ? (G / 8) * (c & 7) + (c >> 3) : c;
        const int L = i * G + cp; const int ntl = __builtin_amdgcn_readfirstlane(tb[32]); const int tot = ntl * npn, nFull = (tot / G) * G, R = tot - nFull; int U; u.half = 0; u.rofs = 0;
        if (R > 0 && 2 * R <= G && L >= nFull) { const int h = L - nFull; if (h >= 2 * R) return false; U = nFull + (h >> 1); u.half = 1; u.rofs = 128 * (h & 1); }
        else { if (L >= tot) return false; U = L; }
        u.pm = U >> lognpn; u.pn = U & (npn - 1); u.e = __builtin_amdgcn_readfirstlane((int)t2e[u.pm]); u.kind = 0; return true; }
    DI const char* abase(const pg8::Gemm& g, const pg8::Unit& u) const { return (const char*)g.A + (size_t)(u.pm * 256 + u.rofs) * g.lda * 2; }
    DI const char* bbase(const pg8::Gemm&, const pg8::Unit& u) const { return (const char*)bw + (size_t)u.e * bexp + (size_t)u.pn * btile; }
    DI int arow(const pg8::Unit& u, int r) const { return slottok[u.pm * 256 + u.rofs + r]; }
};

constexpr int NPH = 17;
template <unsigned MASK>
__global__ void __launch_bounds__(NTHREADS, 2) fwd(Args a) {
    extern __shared__ __attribute__((aligned(16))) unsigned char lds_raw[];
    Ctx c; c.in = (const float* const __attribute__((address_space(4)))*)__builtin_amdgcn_kernarg_segment_ptr(); c.out = a.out; c.ws = a.ws; c.lds = (LAS unsigned char*)lds_raw;
    c.tid = threadIdx.x; c.lane = c.tid & 63; c.wave = __builtin_amdgcn_readfirstlane(c.tid >> 6); c.G = gridDim.x; c.blk = blockIdx.x;
    c.gw = c.blk * NWAVES + c.wave; c.ngw = c.G * NWAVES; c.l = 0;
#define FRESH() do { int t_ = threadIdx.x; asm volatile("" : "+v"(t_)); c.tid = t_; c.lane = t_ & 63; c.wave = __builtin_amdgcn_readfirstlane(t_ >> 6); \
        { int b_ = blockIdx.x, g_ = gridDim.x; asm volatile("" : "+s"(b_), "+s"(g_)); c.blk = b_; c.G = g_; c.ngw = g_ * NWAVES; } c.gw = c.blk * NWAVES + c.wave; \
        size_t z_ = 0; asm volatile("" : "+s"(z_)); c.in = (const float* const __attribute__((address_space(4)))*)__builtin_amdgcn_kernarg_segment_ptr() + z_; c.ws = a.ws + z_; c.out = a.out + z_; c.lds = (LAS unsigned char*)lds_raw + (unsigned)z_; L = c.lds; } while (0)
    volatile LAS unsigned* bst = (volatile LAS unsigned*)(c.lds + LDS_MISC);
    if (c.tid < 4) bst[c.tid] = 0u;
    __syncthreads();
    XcdBarrier bar; bar.bar = (unsigned*)(a.ws + WS_CTL) + CW_BAR; bar.x = 0; bar.st = bst;
#if MK_SINGLE
    bar = xcd_barrier_post((unsigned*)(a.ws + WS_CTL) + CW_BAR, bst);
#define GRID_BAR() xcd_barrier(bar)
#else
#define GRID_BAR() do {} while (0)
#endif
    LAS unsigned char* L = c.lds;
    if (EN(0) && a.pro) { FRESH(); phase_prologue(c); if (!MK_SINGLE) GRID_BAR(); }
    const int lo = a.ph_lo, hi = a.ph_hi; (void)lo; (void)hi;
#if MK_SINGLE
#define IN(k) (EN(k))
#else
#define IN(k) (EN(k) && lo <= (k) && (k) < hi)
#endif
    for (int l = a.l_lo; l < a.l_hi; ++l) {
        c.l = l;
        if (IN(1)) for (int rr = 0; rr < REPN(1); ++rr) { FRESH(); phase_norm_mix(c, rr + 1 < REPN(1)); GRID_BAR(); }
        if (IN(2)) for (int rr = 0; rr < REPN(2); ++rr) { FRESH();
            pg8::Gemm g{c.wsb(WS_HN), c.wsb(WS_WIN + l * WIN_L), DM, DM, DM}; pg8::StaticOrder S; S.init(T, PC, c.G, c.blk);
            pg8::EpiBf16 E{c.wsb(WS_PROJ), PC};
            pg8::gemm_phase<pg8::EpiBf16, pg8::StaticOrder, false>(L, g, S, E); GRID_BAR(); }
        if (IN(4)) for (int rr = 0; rr < REPN(4); ++rr) { FRESH();
            if (rr == 0) phase_prep(c, false);
            FRESH();
            for (int r2_ = 0; r2_ < (REP_PH == 41 ? 2 : 1); ++r2_) { if (SUB(1) && c.blk < 2048) { u32x4 rv[4]; { int t0_ = c.tid; asm volatile("" : "+v"(t0_)); gdn_raw_load(c, c.blk, t0_, rv); }
                for (int it = c.blk; it < 2048; it += c.G) gdn_prep_item(c, it, it + c.G < 2048 ? it + c.G : -1, rv); } }
            FRESH();
            for (int r2_ = 0; r2_ < (REP_PH == 42 ? 2 : 1); ++r2_) { if (SUB(2)) for (int it = c.blk; it < 512; it += c.G) mlstm_prep_mf(c, it); }
            GRID_BAR(); }
        if (IN(5)) for (int rr = 0; rr < REPN(5); ++rr) { FRESH();
            const int cmp_c = (c.G >= 80) ? c.blk - 64 : c.blk;
            if (SUB(0)) { pg8::Gemm g{c.wsb(WS_KCR), c.wsb(WS_CW1), 1024, 2048, 2048};
              CmpOrder S{c.G, cmp_c, c.wsb(WS_KCR), c.wsb(WS_VCR), c.wsb(WS_CW1 + (size_t)(l * 2) * MiB), c.wsb(WS_CW1 + (size_t)(l * 2 + 1) * MiB), (size_t)256 * 1024 * 2};
              pg8::EpiCmp1 E{c.wsb(WS_HID)};
              pg8::gemm_phase<pg8::EpiCmp1, CmpOrder, false>(L, g, S, E);
              __syncthreads();
              if (cmp_c >= 0) for (int u = cmp_c; u < 16; u += c.G) phase_cmp_stage2(c, u * 256, u * 256 + 256, c.wave, NWAVES); }
            __syncthreads();
            const float lam_init = 0.8f - 0.6f * __expf(-0.3f * (float)l);
            float lam_full; { const float* lm = c.in[17] + (size_t)l * 128 + (c.lane & 31); const float s1 = wsum(c.lane < 32 ? lm[0] * lm[32] : 0.f), s2 = wsum(c.lane < 32 ? lm[64] * lm[96] : 0.f); lam_full = __expf(s1) - __expf(s2) + lam_init; }
            FRESH();
            if (SUB(1)) for (int grep_ = 0; grep_ < (EXPT == 11 ? 2 : 1); ++grep_) for (int it = c.blk; it < 32; it += c.G) gdn_scan_item(c, it, c.in[12] + (size_t)l * 64);
            FRESH();
            if (SUB(2)) for (int mrep_ = 0; mrep_ < (EXPT == 12 ? 2 : 1); ++mrep_) for (int it = c.blk; it < 64; it += c.G) if (it >= 32) mlstm_scan_item(c, it - 32);
            FRESH();
            if (SUB(3)) for (int qrep = 0; qrep < (EXPT == 10 ? 2 : 1); ++qrep) { unsigned* qctr = (unsigned*)(c.ws + WS_CTL) + 512 + 64 * (2 * l + rr) + 32 * qrep; volatile LAS unsigned* qs = (volatile LAS unsigned*)(c.lds + LDS_MISC + 32);
                __syncthreads();
                if (c.tid == 0) qs[0] = __hip_atomic_fetch_add(qctr, 1u, __ATOMIC_RELAXED, __HIP_MEMORY_SCOPE_AGENT);
                __syncthreads();
                int k = __builtin_amdgcn_readfirstlane((int)qs[0]);
                while (k < 1024) {
                    unsigned nv = 0u; if (c.tid == 0) nv = __hip_atomic_fetch_add(qctr, 1u, __ATOMIC_RELAXED, __HIP_MEMORY_SCOPE_AGENT);
                    const int qt = 31 - (k >> 5), bh = k & 31;
                    diff_item(c, bh >> 2, bh & 3, qt, lam_full, lam_init);
                    if (c.tid == 0) qs[0] = nv;
                    __syncthreads();
                    k = __builtin_amdgcn_readfirstlane((int)qs[0]);
                } }
            GRID_BAR(); }
        if (IN(7)) for (int rr = 0; rr < REPN(7); ++rr) { FRESH();
            for (int mo_ = 0; mo_ < (EXPT == 21 ? 2 : 1); ++mo_) for (int it = c.blk; it < 512; it += c.G) mlstm_out_mf(c, it);
            FRESH();
            if (SUB(3)) for (int nr_ = 0; nr_ < (EXPT == 20 ? 2 : 1); ++nr_) for (int p = c.blk; p < 256; p += c.G) { const int b = p >> 5, q = p & 31;
#pragma unroll 1
                for (int rep = 0; rep < 2; ++rep) nsa_item(c, b, rep ? q : 63 - q); }
            GRID_BAR(); }
        if (IN(8)) for (int rr = 0; rr < REPN(8); ++rr) { FRESH();
            pg8::Gemm g{c.wsb(WS_HN), c.wsb(WS_WOUT + (size_t)l * 2 * MiB), DM, DM, DM}; pg8::StaticOrder S; S.init(T, DM, c.G, c.blk);
            pg8::EpiResid E{(l == 0) ? c.in[0] : (const float*)nullptr, c.wsb(WS_RES), c.wsb(WS_RES), (rr + 1 < REPN(8)) ? 0.f : 1.f};
            pg8::gemm_phase<pg8::EpiResid, pg8::StaticOrder, false>(L, g, S, E); GRID_BAR(); }
        if (IN(10)) for (int rr = 0; rr < REPN(10); ++rr) { FRESH();
            LAS float* rstab = (LAS float*)(c.lds + LDS_GOFF);
            if (c.blk == 0 && c.tid < 128) c.wsi(WS_MCNT)[c.tid] = 0;
            { int li = 0; for (int u0 = c.blk; u0 < 128; u0 += c.G, ++li) {
                for (int r0 = c.wave; r0 < 256; r0 += 8 * NWAVES) {
                    f32x4 v[8][4];
#pragma unroll
                    for (int j = 0; j < 8; ++j) row_load_bf(c.wsb(WS_RES) + (size_t)(u0 * 256 + r0 + j * NWAVES) * DM, c.lane, v[j]);
#pragma unroll
                    for (int j = 0; j < 8; ++j) { const float rs = rsq(row_ss(v[j]) * (1.f / DM) + EPS); if (c.lane == 0) rstab[(li & 15) * 256 + r0 + j * NWAVES] = rs; } } } }
            __syncthreads();
            pg8::Gemm g{c.wsb(WS_RES), c.wsb(WS_XWQ), DM, DM, DM};
            XqkvOrder S{c.G, c.blk, c.wsb(WS_RES), c.wsb(WS_MEMN + (size_t)l * 4 * MiB), c.wsb(WS_XWQ + (size_t)l * 512 * KiB), c.wsb(WS_XWKV + (size_t)l * MiB)};
            pg8::EpiXqkv E{c.wsb(WS_XQ), c.wsb(WS_XKV), rstab};
            pg8::gemm_phase<pg8::EpiXqkv, XqkvOrder, false>(L, g, S, E);
            __syncthreads();
            { constexpr int NIT = 32 * 384, CUT = (NIT * 85 / 100) & ~7;
              if (c.G > 144) { if (c.blk >= 144) convert_moe_weights(c, 0, CUT, (c.blk - 144) * NWAVES + c.wave, (c.G - 144) * NWAVES); else convert_moe_weights(c, CUT, NIT, c.gw, 144 * NWAVES); }
              else convert_moe_weights(c, 0, NIT, c.gw, c.ngw); }
            GRID_BAR(); }
        if (IN(11)) for (int rr = 0; rr < REPN(11); ++rr) { FRESH(); for (int it = c.blk; it < 512; it += c.G) { const int b = it >> 6, h = (it >> 4) & 3, q = it & 15; xattn_item(c, b, h, q); } GRID_BAR(); }
        if (IN(12)) for (int rr = 0; rr < REPN(12); ++rr) { FRESH();
            pg8::Gemm g{c.wsb(WS_XAO), c.wsb(WS_XWO + (size_t)l * 512 * KiB), 256, 256, 256}; pg8::StaticOrder S; S.init(T, DM, c.G, c.blk);
            pg8::EpiResid E{(const float*)nullptr, c.wsb(WS_RES), c.wsb(WS_RES), (rr + 1 < REPN(12)) ? 0.f : 1.f};
            pg8::gemm_phase<pg8::EpiResid, pg8::StaticOrder, false>(L, g, S, E); GRID_BAR(); }
        if (IN(13)) for (int rr = 0; rr < REPN(13); ++rr) { FRESH(); phase_norm_route(c, rr + 1 < REPN(13)); GRID_BAR(); }
        if (IN(14)) for (int rr = 0; rr < REPN(14); ++rr) { FRESH(); phase_moe_slots(c, rr + 1 < REPN(14)); GRID_BAR(); }
        if (IN(15)) for (int rr = 0; rr < REPN(15); ++rr) { FRESH();
            LAS int* tb = (LAS int*)(c.lds + LDS_MISC + 64); LAS unsigned char* t2e = (LAS unsigned char*)(c.lds + LDS_MISC + 256);
            moe_tiles(c, tb, t2e);
            pg8::Gemm g{c.wsb(WS_RES), c.wsb(WS_MW13), DM, DM, DM};
            MoeOrder S{c.G, c.blk, 2, 1, tb, t2e, c.wsi(WS_SLOTTOK), c.wsb(WS_MW13), (size_t)MiB, (size_t)256 * DM * 2};
            pg8::EpiSwiglu E{c.wsb(WS_ACT), c.wsi(WS_SLOTTOK), c.wsf(WS_RS)};
            pg8::gemm_phase<pg8::EpiSwiglu, MoeOrder, true>(L, g, S, E); GRID_BAR(); }
        if (IN(16)) for (int rr = 0; rr < REPN(16); ++rr) { FRESH();
            LAS int* tb = (LAS int*)(c.lds + LDS_MISC + 64); LAS unsigned char* t2e = (LAS unsigned char*)(c.lds + LDS_MISC + 256);
            moe_tiles(c, tb, t2e);
            pg8::Gemm g{c.wsb(WS_ACT), c.wsb(WS_MW2), 256, 256, 256};
            MoeOrder S{c.G, c.blk, 4, 2, tb, t2e, c.wsi(WS_SLOTTOK), c.wsb(WS_MW2), (size_t)512 * KiB, (size_t)256 * 256 * 2};
            pg8::EpiBf16 E{c.wsb(WS_YMOE), DM};
            pg8::gemm_phase<pg8::EpiBf16, MoeOrder, false>(L, g, S, E); GRID_BAR(); }
    }
    if (EN(17) && a.fin) { FRESH(); phase_final(c); }
#undef IN
}

typedef void (*KernFn)(Args);
template <unsigned MASK> static bool prep_kernel() {
    return hipFuncSetAttribute((const void*)fwd<MASK>, hipFuncAttributeMaxDynamicSharedMemorySize, LDS_BYTES) == hipSuccess;
}
#if !MK_SINGLE
template <int P> static void launch_phase(int grid, hipStream_t stream, const Args& a) { hipLaunchKernelGGL(fwd<(1u << P)>, dim3(grid), dim3(NTHREADS), LDS_BYTES, stream, a); }
static void launch_phase_rt(int p, int grid, hipStream_t stream, const Args& a) {
    switch (p) {
        case 0: launch_phase<0>(grid, stream, a); break;   case 1: launch_phase<1>(grid, stream, a); break;   case 2: launch_phase<2>(grid, stream, a); break;
        case 3: launch_phase<3>(grid, stream, a); break;   case 4: launch_phase<4>(grid, stream, a); break;   case 5: launch_phase<5>(grid, stream, a); break;
        case 6: launch_phase<6>(grid, stream, a); break;   case 7: launch_phase<7>(grid, stream, a); break;   case 8: launch_phase<8>(grid, stream, a); break;
        case 9: launch_phase<9>(grid, stream, a); break;   case 10: launch_phase<10>(grid, stream, a); break; case 11: launch_phase<11>(grid, stream, a); break;
        case 12: launch_phase<12>(grid, stream, a); break; case 13: launch_phase<13>(grid, stream, a); break; case 14: launch_phase<14>(grid, stream, a); break;
        case 15: launch_phase<15>(grid, stream, a); break; case 16: launch_phase<16>(grid, stream, a); break; case 17: launch_phase<17>(grid, stream, a); break;
        default: break;
    }
}
template <int P> static bool prep_all() { if (!prep_kernel<(1u << P)>()) return false; if constexpr (P > 0) return prep_all<P - 1>(); else return true; }
#endif
extern "C" void kernel_launch(void* const* d_in, const int* in_sizes, int n_in, void* d_out, int out_size, void* d_ws, size_t ws_size, hipStream_t stream) {
    static int grid = 0;
    if (grid == 0) {
        if (n_in != 33 || out_size != T * DM || ws_size < WS_END) { fprintf(stderr, "kernel_launch: unexpected problem (n_in %d, out %d, ws %zu)\n", n_in, out_size, ws_size); grid = -1; return; }
        int dev = 0, cus = 0, per_cu = 0;
        if (hipGetDevice(&dev) != hipSuccess || hipDeviceGetAttribute(&cus, hipDeviceAttributeMultiprocessorCount, dev) != hipSuccess) { grid = -1; return; }
#if MK_SINGLE
        if (!prep_kernel<0xFFFFFFFFu>()) { fprintf(stderr, "kernel_launch: hipFuncSetAttribute failed\n"); grid = -1; return; }
        if (hipOccupancyMaxActiveBlocksPerMultiprocessor(&per_cu, (const void*)fwd<0xFFFFFFFFu>, NTHREADS, LDS_BYTES) != hipSuccess || per_cu < 1) fprintf(stderr, "kernel_launch: occupancy query reports %d\n", per_cu);
#else
        if (!prep_all<17>()) { fprintf(stderr, "kernel_launch: hipFuncSetAttribute failed\n"); grid = -1; return; }
        (void)per_cu;
#endif
        (void)hipGetLastError();
        grid = cus;
    }
    if (grid < 0) return;
    (void)hipMemsetAsync((char*)d_ws + WS_CTL, 0, CTL_ZERO_BYTES, stream);
    Args a{};
    for (int i = 0; i < 33; ++i) a.in[i] = (const float*)d_in[i];
    a.out = (float*)d_out; a.ws = (unsigned char*)d_ws;
#if MK_SINGLE
    a.l_lo = 0; a.l_hi = 2; a.ph_lo = 1; a.ph_hi = NPH; a.pro = 1; a.fin = 1;
    hipLaunchKernelGGL(fwd<0xFFFFFFFFu>, dim3(grid), dim3(NTHREADS), LDS_BYTES, stream, a);
#else
    a.l_lo = 0; a.l_hi = 0; a.ph_lo = 0; a.ph_hi = 0; a.pro = 1; a.fin = 0;
    launch_phase_rt(0, grid, stream, a);
    a.pro = 0;
    for (int l = 0; l < 2; ++l) for (int p = 1; p < NPH; ++p) { a.l_lo = l; a.l_hi = l + 1; a.ph_lo = p; a.ph_hi = p + 1; launch_phase_rt(p, grid, stream, a); }
    a.l_lo = 0; a.l_hi = 0; a.ph_lo = 0; a.ph_hi = 0; a.fin = 1;
    launch_phase_rt(17, grid, stream, a);
#endif
}
```
